# Optimizing an MI355X kernel written in HIP

```python
import jax, jax.numpy as jnp
from jax import lax
import numpy as np

D_MODEL = 1024
BATCH = 32
SEQ = 256
DEPTH = 2
DEC_BATCH = 2
DEC_SEQ = 4096
PAST_LEN = 256

GRID_W = 64
N_MOD = 6
EPS = 1e-6
N_HEADS = 8
N_KV_HEADS = 2
HEAD_DIM = 64
ATTN_W = N_HEADS * HEAD_DIM
KV_W = N_KV_HEADS * HEAD_DIM
Q_BLOCK = 128
ROPE_THETA = 10000.0
HY_CH = 256
HY_GROUPS = 4
HY_SHORT = 3
HY_BANDS = 16
HY_EMB = 1 + 2 * HY_BANDS
HY_FFN = 64
HY_FILTER_STD = 0.01
HY_DECAY_MIN = 3.07
HY_DECAY_MAX = 15.35
SG_W = 256
SG_GROUPS = 4
SG_GROUP_W = SG_W // SG_GROUPS
CHUNK = 128
MIX_W = ATTN_W + HY_CH + SG_W
Q_END = ATTN_W
K_END = Q_END + KV_W
V_END = K_END + KV_W
HY_END = V_END + 3 * HY_CH
IN_W = HY_END + 2 * SG_W
PEER_HEADS = 8
N_KEYS = 128
N_EXPERTS = N_KEYS * N_KEYS
PEER_KEY_DIM = 128
PEER_HALF = PEER_KEY_DIM // 2
PEER_TOPK = 16
TOKEN_BLOCK = 128

kernel_name = 'hyena_gmlp_gqa_peer_prefix_dit_step'

F32 = jnp.float32


def rmsnorm(x, g):
    xf = x.astype(F32)
    y = xf * lax.rsqrt(jnp.mean(xf * xf, axis=-1, keepdims=True) + EPS)
    return (y * g.astype(F32)).astype(x.dtype)


def rope_2d_tables(L):
    rows = L // GRID_W
    row = jnp.broadcast_to(jnp.arange(rows, dtype=F32)[:, None], (rows, GRID_W)).reshape(L)
    col = jnp.broadcast_to(jnp.arange(GRID_W, dtype=F32)[None, :], (rows, GRID_W)).reshape(L)
    n_axis = HEAD_DIM // 4
    inv = ROPE_THETA ** (-jnp.arange(n_axis, dtype=F32) / n_axis)
    ang = jnp.concatenate([row[:, None] * inv, col[:, None] * inv], axis=-1)
    return jnp.cos(ang), jnp.sin(ang)


def apply_rope(x, cos, sin):
    B, L, H, _ = x.shape
    xp = x.astype(F32).reshape(B, L, H, HEAD_DIM // 2, 2)
    a, b = xp[..., 0], xp[..., 1]
    c = cos[None, :, None, :]
    s = sin[None, :, None, :]
    out = jnp.stack([a * c - b * s, a * s + b * c], axis=-1).reshape(B, L, H, HEAD_DIM)
    return out.astype(x.dtype)


def attention(q, k, v):
    B, Lq, H, Dh = q.shape
    G = N_HEADS // N_KV_HEADS
    nb = Lq // Q_BLOCK
    qb = q.reshape(B, nb, Q_BLOCK, N_KV_HEADS, G, Dh).transpose(1, 0, 2, 3, 4, 5)
    scale = HEAD_DIM ** -0.5

    def block(qblk):
        s = jnp.einsum('bqkgd,bskd->bkgqs', qblk, k).astype(F32) * scale
        p = jax.nn.softmax(s, axis=-1).astype(v.dtype)
        return jnp.einsum('bkgqs,bskd->bqkgd', p, v)

    o = lax.map(block, qb)
    return o.transpose(1, 0, 2, 3, 4, 5).reshape(B, Lq, H * Dh)


def short_conv(z, w, b):
    zp = jnp.pad(z, ((0, 0), (1, 1), (0, 0)))
    return zp[:, :-2] * w[0] + zp[:, 1:-1] * w[1] + zp[:, 2:] * w[2] + b


def hyena_filter_fft(L, fw1, fb1, fr1, fw2, fb2, fr2, fw3, decay):
    t = jnp.arange(L, dtype=F32)
    tn = t / (L - 1)
    w = 2.0 * jnp.pi * t / L
    f = jnp.linspace(1e-4, HY_BANDS - 1, HY_BANDS, dtype=F32)
    zf = w[:, None] * f[None, :]
    feats = jnp.concatenate([tn[:, None], jnp.cos(zf), -jnp.sin(zf)], axis=-1)
    h = jnp.sin(fr1.astype(F32) * (feats @ fw1.astype(F32) + fb1.astype(F32)))
    h = jnp.sin(fr2.astype(F32) * (h @ fw2.astype(F32) + fb2.astype(F32)))
    h = (h @ fw3.astype(F32)).reshape(L, 2, HY_CH)
    h = h * jnp.exp(-tn[:, None, None] * jnp.abs(decay.astype(F32)))
    fwd, bwd = h[:, 0], h[:, 1]
    full = jnp.concatenate([fwd, jnp.zeros((1, HY_CH), F32), bwd[:0:-1]], axis=0)
    return jnp.fft.rfft(full, axis=0)


def hyena(z, P):
    B, L, _ = z.shape
    z = short_conv(z, P['hy_conv_w'], P['hy_conv_b'])
    x0, x1, v = jnp.split(z, 3, axis=-1)
    u = (x1 * v).astype(F32)
    Hf = hyena_filter_fft(L, P['hy_fw1'], P['hy_fb1'], P['hy_freq1'], P['hy_fw2'],
                          P['hy_fb2'], P['hy_freq2'], P['hy_fw3'], P['hy_decay'])
    U = jnp.fft.rfft(u, n=2 * L, axis=1)
    conv = jnp.fft.irfft(U * Hf[None], n=2 * L, axis=1)[:, :L]
    y = x0.astype(F32) * (conv + u * P['hy_skip'].astype(F32))
    return y.astype(z.dtype)


def chunk_gmlp(z, g, ws, bs):
    B, L, _ = z.shape
    u, v = jnp.split(jax.nn.gelu(z), 2, axis=-1)
    v = rmsnorm(v, g).reshape(B, L // CHUNK, CHUNK, SG_GROUPS, SG_GROUP_W)
    v = jnp.einsum('hpq,bnqhc->bnphc', ws, v) + bs.T[None, None, :, :, None]
    return u * v.reshape(B, L, SG_W)


def peer(h, wq, keys, u_tab, v_tab):
    B, L, D = h.shape
    T = B * L
    x = h.reshape(T, D)
    q = (x @ wq).reshape(T, PEER_HEADS, 2, PEER_HALF)
    s = jnp.einsum('thpd,hpnd->thpn', q, keys).astype(F32)
    s_top, i_top = lax.top_k(s, PEER_TOPK)
    cand = (s_top[:, :, 0, :, None] + s_top[:, :, 1, None, :]).reshape(T, PEER_HEADS, PEER_TOPK * PEER_TOPK)
    cidx = (i_top[:, :, 0, :, None] * N_KEYS + i_top[:, :, 1, None, :]).reshape(T, PEER_HEADS, PEER_TOPK * PEER_TOPK)
    sc, pos = lax.top_k(cand, PEER_TOPK)
    idx = jnp.take_along_axis(cidx, pos, axis=-1)
    gate = jax.nn.softmax(sc, axis=-1)
    nb = T // TOKEN_BLOCK
    E = PEER_HEADS * PEER_TOPK
    xb = x.reshape(nb, TOKEN_BLOCK, D)
    ib = idx.reshape(nb, TOKEN_BLOCK, E)
    gb = gate.reshape(nb, TOKEN_BLOCK, E).astype(x.dtype)

    def block(args):
        xt, it, gt = args
        ue = jnp.take(u_tab, it, axis=0)
        ve = jnp.take(v_tab, it, axis=0)
        a = jax.nn.gelu(jnp.einsum('td,ted->te', xt, ue))
        return jnp.einsum('te,ted->td', gt * a, ve)

    out = lax.map(block, (xb, ib, gb))
    return out.reshape(B, L, D)


def layer(x, mod, P, rope, k_ext, v_ext):
    B, L, _ = x.shape
    sh_m, sc_m, g_m, sh_f, sc_f, g_f = jnp.split(mod, N_MOD, axis=-1)
    h = rmsnorm(x, P['norm_mix_g']) * (1.0 + sc_m) + sh_m
    proj = h @ P['w_in']
    q = rmsnorm(proj[..., :Q_END].reshape(B, L, N_HEADS, HEAD_DIM), P['q_norm_g'])
    k = rmsnorm(proj[..., Q_END:K_END].reshape(B, L, N_KV_HEADS, HEAD_DIM), P['k_norm_g'])
    v = proj[..., K_END:V_END].reshape(B, L, N_KV_HEADS, HEAD_DIM)
    if rope is None:
        attn = attention(q, k, v)
    else:
        cos, sin = rope
        q_r = apply_rope(q, cos, sin)
        k_r = apply_rope(k, cos, sin)
        k_all = jnp.concatenate([k_ext.astype(k_r.dtype), k_r], axis=1)
        v_all = jnp.concatenate([v_ext.astype(v.dtype), v], axis=1)
        attn = attention(q_r, k_all, v_all)
    hy = hyena(proj[..., V_END:HY_END], P)
    sg = chunk_gmlp(proj[..., HY_END:], P['sg_norm_g'], P['sg_w'], P['sg_b'])
    mixed = jnp.concatenate([attn, hy.astype(attn.dtype), sg.astype(attn.dtype)], axis=-1) @ P['w_out']
    x = x + g_m * mixed
    h = rmsnorm(x, P['norm_ffn_g']) * (1.0 + sc_f) + sh_f
    x = x + g_f * peer(h, P['peer_wq'], P['peer_keys'], P['peer_u'], P['peer_v'])
    return x, k, v


def setup_inputs(seed: int = 0) -> dict:
    key = jax.random.key(seed)
    ks = iter(jax.random.split(key, 40))
    D = D_MODEL

    def nrm(shape, std):
        return std * jax.random.normal(next(ks), shape, jnp.float32)

    def gain(shape):
        return 1.0 + nrm(shape, 0.02)

    return {
        'x_prompt': nrm((BATCH, SEQ, D), 1.0),
        'x_sample': nrm((DEC_BATCH, DEC_SEQ, D), 1.0),
        'cache_k': nrm((DEC_BATCH, DEPTH, PAST_LEN, N_KV_HEADS, HEAD_DIM), 1.0),
        'cache_v': nrm((DEC_BATCH, DEPTH, PAST_LEN, N_KV_HEADS, HEAD_DIM), 1.0),
        'c': nrm((DEC_BATCH, D), 1.0),
        'c_ctx': nrm((D,), 1.0),
        'norm_mix_g': gain((DEPTH, D)),
        'norm_ffn_g': gain((DEPTH, D)),
        'ada_w': nrm((DEPTH, D, N_MOD * D), D ** -0.5),
        'ada_b': nrm((DEPTH, N_MOD * D), 0.01),
        'w_in': nrm((DEPTH, D, IN_W), D ** -0.5),
        'w_out': nrm((DEPTH, MIX_W, D), MIX_W ** -0.5),
        'q_norm_g': gain((DEPTH, HEAD_DIM)),
        'k_norm_g': gain((DEPTH, HEAD_DIM)),
        'hy_conv_w': nrm((DEPTH, HY_SHORT, 3 * HY_CH), HY_SHORT ** -0.5),
        'hy_conv_b': nrm((DEPTH, 3 * HY_CH), 0.01),
        'hy_fw1': nrm((DEPTH, HY_EMB, HY_FFN), HY_EMB ** -0.5),
        'hy_fb1': nrm((DEPTH, HY_FFN), 0.1),
        'hy_freq1': 1.0 + nrm((DEPTH, HY_FFN), 0.1),
        'hy_fw2': nrm((DEPTH, HY_FFN, HY_FFN), HY_FFN ** -0.5),
        'hy_fb2': nrm((DEPTH, HY_FFN), 0.1),
        'hy_freq2': 1.0 + nrm((DEPTH, HY_FFN), 0.1),
        'hy_fw3': nrm((DEPTH, HY_FFN, 2 * HY_CH), HY_FILTER_STD),
        'hy_decay': jax.random.uniform(next(ks), (DEPTH, 2, HY_CH), jnp.float32, HY_DECAY_MIN, HY_DECAY_MAX),
        'hy_skip': nrm((DEPTH, HY_CH), 1.0),
        'sg_norm_g': gain((DEPTH, SG_W)),
        'sg_w': nrm((DEPTH, SG_GROUPS, CHUNK, CHUNK), CHUNK ** -0.5),
        'sg_b': 1.0 + nrm((DEPTH, SG_GROUPS, CHUNK), 0.02),
        'peer_wq': nrm((DEPTH, D, PEER_HEADS * PEER_KEY_DIM), D ** -0.5),
        'peer_keys': nrm((DEPTH, PEER_HEADS, 2, N_KEYS, PEER_HALF), PEER_HALF ** -0.5),
        'peer_u': nrm((DEPTH, N_EXPERTS, D), D ** -0.5),
        'peer_v': nrm((DEPTH, N_EXPERTS, D), (PEER_HEADS * PEER_TOPK) ** -0.5),
    }


def reference(x_prompt, x_sample, cache_k, cache_v, c, c_ctx, norm_mix_g, norm_ffn_g, ada_w, ada_b,
              w_in, w_out, q_norm_g, k_norm_g, hy_conv_w, hy_conv_b, hy_fw1, hy_fb1, hy_freq1,
              hy_fw2, hy_fb2, hy_freq2, hy_fw3, hy_decay, hy_skip, sg_norm_g, sg_w, sg_b,
              peer_wq, peer_keys, peer_u, peer_v):
    rope = rope_2d_tables(x_sample.shape[1])
    y_p = x_prompt
    y_s = x_sample
    ks_ctx = []
    vs_ctx = []
    for l in range(DEPTH):
        P = {
            'norm_mix_g': norm_mix_g[l], 'norm_ffn_g': norm_ffn_g[l],
            'w_in': w_in[l], 'w_out': w_out[l],
            'q_norm_g': q_norm_g[l], 'k_norm_g': k_norm_g[l],
            'hy_conv_w': hy_conv_w[l], 'hy_conv_b': hy_conv_b[l],
            'hy_fw1': hy_fw1[l], 'hy_fb1': hy_fb1[l], 'hy_freq1': hy_freq1[l],
            'hy_fw2': hy_fw2[l], 'hy_fb2': hy_fb2[l], 'hy_freq2': hy_freq2[l],
            'hy_fw3': hy_fw3[l], 'hy_decay': hy_decay[l], 'hy_skip': hy_skip[l],
            'sg_norm_g': sg_norm_g[l], 'sg_w': sg_w[l], 'sg_b': sg_b[l],
            'peer_wq': peer_wq[l], 'peer_keys': peer_keys[l],
            'peer_u': peer_u[l], 'peer_v': peer_v[l],
        }
        mod_ctx = (jax.nn.silu(c_ctx)[None, :] @ ada_w[l] + ada_b[l])[:, None, :]
        mod_lat = (jax.nn.silu(c) @ ada_w[l] + ada_b[l])[:, None, :]
        y_p, k_l, v_l = layer(y_p, mod_ctx, P, None, None, None)
        ks_ctx.append(k_l)
        vs_ctx.append(v_l)
        y_s, _, _ = layer(y_s, mod_lat, P, rope, cache_k[:, l], cache_v[:, l])
    new_cache_k = jnp.stack(ks_ctx, axis=1)
    new_cache_v = jnp.stack(vs_ctx, axis=1)
    return (y_p, y_s, new_cache_k, new_cache_v)
```

```cpp
#include <hip/hip_runtime.h>
#include <hip/hip_cooperative_groups.h>
#include <cstdio>
#include <cstdint>
namespace cg = cooperative_groups;

#ifndef PEER_PART
#define PEER_PART 0
#endif
#ifndef ONE_LAUNCH
#define ONE_LAUNCH 1
#endif

typedef unsigned short u16;
typedef __attribute__((ext_vector_type(8))) short bf16x8;
typedef __attribute__((ext_vector_type(16))) float f32x16;
typedef __attribute__((ext_vector_type(4))) float f32x4;
typedef __attribute__((ext_vector_type(2))) float f32x2;

constexpr int DM = 1024;
constexpr int TP = 8192;
constexpr int TT = 16384;
constexpr int LS = 4096;
constexpr int LP = 256;
constexpr int NKS = 4352;
constexpr int INW = 2048;
constexpr int HFS_STRIDE = 8208;
constexpr int HFS_OFF = 4112;
constexpr int HFP_STRIDE = 528;
constexpr int HFP_OFF = 272;

constexpr size_t al(size_t x) { return (x + 255) & ~(size_t)255; }
constexpr size_t OFF_MOD  = 0;
constexpr size_t OFF_ROPE = al(OFF_MOD + (size_t)2 * 3 * 6144 * 4);
constexpr size_t OFF_WTIN = al(OFF_ROPE + (size_t)4096 * 32 * 8);
constexpr size_t OFF_WTOUT = al(OFF_WTIN + (size_t)2 * 2048 * 1024 * 2);
constexpr size_t OFF_WTQ  = al(OFF_WTOUT + (size_t)2 * 1024 * 1024 * 2);
constexpr size_t OFF_KEYS = al(OFF_WTQ + (size_t)2 * 1024 * 1024 * 2);
constexpr size_t OFF_WSB  = al(OFF_KEYS + (size_t)2 * 8 * 2 * 128 * 64 * 2);
constexpr size_t OFF_HFS  = al(OFF_WSB + (size_t)2 * 4 * 128 * 128 * 2);
constexpr size_t OFF_HFP  = al(OFF_HFS + (size_t)2 * 256 * HFS_STRIDE * 4);
constexpr size_t OFF_HBUF = al(OFF_HFP + (size_t)2 * 256 * HFP_STRIDE * 4);
constexpr size_t OFF_PROJ = al(OFF_HBUF + (size_t)TT * 1024 * 2);
constexpr size_t OFF_QN   = al(OFF_PROJ + (size_t)TT * 2048 * 2);
constexpr size_t OFF_KP   = al(OFF_QN + (size_t)TT * 512 * 2);
constexpr size_t OFF_VTP  = al(OFF_KP + (size_t)32 * 2 * 256 * 64 * 2);
constexpr size_t OFF_KS   = al(OFF_VTP + (size_t)32 * 2 * 64 * 256 * 2);
constexpr size_t OFF_VTS  = al(OFF_KS + (size_t)2 * 2 * NKS * 64 * 2);
constexpr size_t OFF_UB   = al(OFF_VTS + (size_t)2 * 2 * 64 * NKS * 2);
constexpr size_t OFF_X0   = al(OFF_UB + (size_t)TT * 256 * 2);
constexpr size_t OFF_UG   = al(OFF_X0 + (size_t)TT * 256 * 2);
constexpr size_t OFF_VGN  = al(OFF_UG + (size_t)TT * 256 * 2);
constexpr size_t OFF_MIX  = al(OFF_VGN + (size_t)TT * 256 * 2);
constexpr size_t OFF_QP   = al(OFF_MIX + (size_t)TT * 1024 * 2);
constexpr size_t OFF_UT   = al(OFF_QP + (size_t)TT * 1024 * 2);
constexpr size_t OFF_VT   = al(OFF_UT + (size_t)2 * 16384 * 1024);
constexpr size_t OFF_UTB  = al(OFF_VT + (size_t)2 * 16384 * 1024);
constexpr size_t OFF_KMAX = al(OFF_UTB + (size_t)2 * 256 * 4096 * 2);
constexpr size_t OFF_GIDX = al(OFF_KMAX + 1024);
constexpr size_t OFF_GGATE = al(OFF_GIDX + (size_t)TT * 128 * 2);
constexpr size_t OFF_ABUF = al(OFF_GGATE + (size_t)TT * 128 * 4);
constexpr size_t OFF_BAR  = al(OFF_ABUF + (size_t)TT * 128 * 4);
constexpr size_t OFF_QHEAD = OFF_BAR + 14336;
constexpr size_t WS_NEED  = al(OFF_BAR + 16384);

struct Params {
  const float *x_prompt, *x_sample, *cache_k, *cache_v, *c, *c_ctx, *norm_mix_g, *norm_ffn_g, *ada_w, *ada_b,
      *w_in, *w_out, *q_norm_g, *k_norm_g, *hy_conv_w, *hy_conv_b, *hy_fw1, *hy_fb1, *hy_freq1, *hy_fw2, *hy_fb2,
      *hy_freq2, *hy_fw3, *hy_decay, *hy_skip, *sg_norm_g, *sg_w, *sg_b, *peer_wq, *peer_keys, *peer_u, *peer_v;
  float* out;
  char* ws;
};

__device__ __forceinline__ u16 f2bf(float f) {
  unsigned u = __float_as_uint(f);
  u += 0x7FFFu + ((u >> 16) & 1u);
  return (u16)(u >> 16);
}
__device__ __forceinline__ float bf2f(u16 h) { return __uint_as_float(((unsigned)h) << 16); }
typedef __attribute__((ext_vector_type(2))) __bf16 bf16x2v;
__device__ __forceinline__ unsigned pk2(float lo, float hi) {
  __attribute__((ext_vector_type(2))) float v = {lo, hi};
  bf16x2v b = __builtin_convertvector(v, bf16x2v);
  return __builtin_bit_cast(unsigned, b);
}
__device__ __forceinline__ float gelu_t(float x) {
  float u = 0.7978845608028654f * (x + 0.044715f * x * x * x);
  float e = __expf(2.0f * u);
  float t = 1.0f - 2.0f / (e + 1.0f);
  return 0.5f * x * (1.0f + t);
}
__device__ __forceinline__ float wave_sum(float v) {
  v += __shfl_xor(v, 32); v += __shfl_xor(v, 16); v += __shfl_xor(v, 8);
  v += __shfl_xor(v, 4);  v += __shfl_xor(v, 2);  v += __shfl_xor(v, 1);
  return v;
}
__device__ __forceinline__ int mod_index(int tok) { return tok < TP ? 0 : 1 + ((tok - TP) >> 12); }
__device__ __forceinline__ const float* x_in_row(const Params& p, int l, int tok) {
  if (l == 0) return tok < TP ? p.x_prompt + (size_t)tok * DM : p.x_sample + (size_t)(tok - TP) * DM;
  return p.out + (size_t)tok * DM;
}
__device__ __forceinline__ int otid() { int t = __builtin_amdgcn_workitem_id_x(); asm volatile("" : "+v"(t)); return t; }
__device__ __forceinline__ int obid() { int t = __builtin_amdgcn_workgroup_id_x(); asm volatile("" : "+s"(t)); return t; }
#define MFMA32(a, b, c) __builtin_amdgcn_mfma_f32_32x32x16_bf16(a, b, c, 0, 0, 0)

__device__ __forceinline__ void ph0_mod(const Params& p, int it, float* sm) {
  const int tid = otid();
  int l = it / 48, ch = it % 48;
  const int col0 = ch * 128;
  float* sv = sm;
  for (int i = tid; i < 3072; i += 256) {
    int v = i >> 10, k = i & 1023;
    float cv = (v == 0) ? p.c_ctx[k] : p.c[(v - 1) * 1024 + k];
    sv[i] = cv / (1.0f + expf(-cv));
  }
  __syncthreads();
  const int cg4 = tid & 31, kg = tid >> 5;
  const float* w = p.ada_w + ((size_t)l * 1024 + kg * 128) * 6144 + col0 + cg4 * 4;
  float4 acc[3];
#pragma unroll
  for (int v = 0; v < 3; ++v) acc[v] = make_float4(0.f, 0.f, 0.f, 0.f);
  for (int k8 = 0; k8 < 128; k8 += 8) {
    float4 wr[8];
#pragma unroll
    for (int k = 0; k < 8; ++k) wr[k] = *(const float4*)(w + (size_t)(k8 + k) * 6144);
#pragma unroll
    for (int k = 0; k < 8; ++k)
#pragma unroll
      for (int v = 0; v < 3; ++v) {
        float sc = sv[v * 1024 + kg * 128 + k8 + k];
        acc[v].x += sc * wr[k].x; acc[v].y += sc * wr[k].y; acc[v].z += sc * wr[k].z; acc[v].w += sc * wr[k].w;
      }
  }
  float4* red = (float4*)(sm + 3072);
#pragma unroll
  for (int v = 0; v < 3; ++v) red[(kg * 3 + v) * 32 + cg4] = acc[v];
  __syncthreads();
  if (tid < 96) {
    int v = tid >> 5, cc = tid & 31;
    float4 s4 = *(const float4*)(p.ada_b + l * 6144 + col0 + cc * 4);
    for (int g = 0; g < 8; ++g) {
      float4 r = red[(g * 3 + v) * 32 + cc];
      s4.x += r.x; s4.y += r.y; s4.z += r.z; s4.w += r.w;
    }
    float* mod = (float*)(p.ws + OFF_MOD);
    *(float4*)(mod + (l * 3 + v) * 6144 + col0 + cc * 4) = s4;
  }
  __syncthreads();
}

__device__ __forceinline__ void ph0_transpose(const float* src, u16* dst, int K, int N, int k0, int n0, float* sm) {
  const int tid = otid();
#pragma unroll
  for (int i = 0; i < 16; ++i) {
    int idx = tid + 256 * i, r = idx >> 6, cc = idx & 63;
    sm[r * 65 + cc] = src[(size_t)(k0 + r) * N + n0 + cc];
  }
  __syncthreads();
#pragma unroll
  for (int i = 0; i < 16; ++i) {
    int idx = tid + 256 * i, r = idx >> 6, cc = idx & 63;
    dst[(size_t)(n0 + r) * K + k0 + cc] = f2bf(sm[cc * 65 + r]);
  }
  __syncthreads();
}

__device__ __forceinline__ void ph0_filter(const Params& p, int l, int L, int t0, float* dst, int stride, int off, float* sm) {
  const int tid = otid();
  float* feats = sm;
  float* h1 = sm + 16 * 33;
  float* h2 = h1 + 16 * 64;
  for (int idx = tid; idx < 16 * 33; idx += 256) {
    int tt = idx / 33, j = idx % 33;
    float t = (float)(t0 + tt);
    float val;
    if (j == 0) val = t / (float)(L - 1);
    else {
      int b = (j - 1) & 15;
      float f = 1e-4f + (float)b * ((15.0f - 1e-4f) / 15.0f);
      float w = 2.0f * 3.14159265358979323846f * t / (float)L;
      float z = w * f;
      val = (j <= 16) ? cosf(z) : -sinf(z);
    }
    feats[idx] = val;
  }
  __syncthreads();
  {
    int j = tid & 63, tq = tid >> 6;
    const float* fw1 = p.hy_fw1 + l * 33 * 64;
    float fb = p.hy_fb1[l * 64 + j], fr = p.hy_freq1[l * 64 + j];
    for (int q = 0; q < 4; ++q) {
      int tt = tq * 4 + q;
      float s = fb;
      for (int i = 0; i < 33; ++i) s += feats[tt * 33 + i] * fw1[i * 64 + j];
      h1[tt * 64 + j] = sinf(fr * s);
    }
  }
  __syncthreads();
  {
    int j = tid & 63, tq = tid >> 6;
    const float* fw2 = p.hy_fw2 + l * 64 * 64;
    float fb = p.hy_fb2[l * 64 + j], fr = p.hy_freq2[l * 64 + j];
    for (int q = 0; q < 4; ++q) {
      int tt = tq * 4 + q;
      float s = fb;
      for (int i = 0; i < 64; ++i) s += h1[tt * 64 + i] * fw2[i * 64 + j];
      h2[tt * 64 + j] = sinf(fr * s);
    }
  }
  __syncthreads();
  {
    const float* fw3 = p.hy_fw3 + (size_t)l * 64 * 512;
    float acc0[16], acc1[16];
#pragma unroll
    for (int t = 0; t < 16; ++t) { acc0[t] = 0.f; acc1[t] = 0.f; }
    for (int j = 0; j < 64; ++j) {
      float wa = fw3[j * 512 + tid], wb = fw3[j * 512 + 256 + tid];
#pragma unroll
      for (int t = 0; t < 16; ++t) {
        float hv = h2[t * 64 + j];
        acc0[t] += hv * wa; acc1[t] += hv * wb;
      }
    }
    float d0 = fabsf(p.hy_decay[l * 512 + tid]), d1 = fabsf(p.hy_decay[l * 512 + 256 + tid]);
#pragma unroll
    for (int t = 0; t < 16; ++t) {
      int tg = t0 + t;
      float tn = (float)tg / (float)(L - 1);
      acc0[t] *= expf(-tn * d0);
      acc1[t] *= expf(-tn * d1);
    }
    u16* rc = (u16*)dst + (size_t)tid * stride;
    const int roff = off;
#pragma unroll
    for (int t = 0; t < 16; ++t) {
      const int tg = t0 + t;
      rc[roff - tg] = f2bf(acc0[t]);
      if (tg >= 1) rc[roff + tg] = f2bf(acc1[t]);
    }
    if (t0 == 0) {
      for (int i = 0; i <= roff - L; ++i) rc[i] = (u16)0;
    }
  }
  __syncthreads();
}

constexpr int P0_MOD = 96;
constexpr int P0_TIN = 1024, P0_TOUT = 512, P0_TQ = 512;
constexpr int P0_KEYS = 256, P0_SGW = 128, P0_ROPE = 512;
constexpr int P0_FS = 512, P0_FP = 32;
constexpr int P0_TAB = 4096;
constexpr int P0_TOTAL = P0_MOD + P0_TIN + P0_TOUT + P0_TQ + P0_KEYS + P0_SGW + P0_ROPE + P0_FS + P0_FP;

__device__ __forceinline__ void phase0(const Params& p, float* sm) {
  const int tid = otid();
  if (obid() == 0 && tid < 136) ((unsigned*)(p.ws + OFF_KMAX))[tid] = 0u;
  for (int it0 = obid(); it0 < P0_TOTAL; it0 += gridDim.x) {
    int it = it0;
    if (it < P0_MOD) { ph0_mod(p, it, sm); continue; }
    it -= P0_MOD;
    if (it < P0_TIN) {
      int l = it >> 9, r = it & 511, kt = r >> 5, nt = r & 31;
      ph0_transpose(p.w_in + (size_t)l * 1024 * 2048, (u16*)(p.ws + OFF_WTIN) + (size_t)l * 2048 * 1024, 1024, 2048, kt * 64, nt * 64, sm);
      continue;
    }
    it -= P0_TIN;
    if (it < P0_TOUT) {
      int l = it >> 8, r = it & 255, kt = r >> 4, nt = r & 15;
      ph0_transpose(p.w_out + (size_t)l * 1024 * 1024, (u16*)(p.ws + OFF_WTOUT) + (size_t)l * 1024 * 1024, 1024, 1024, kt * 64, nt * 64, sm);
      continue;
    }
    it -= P0_TOUT;
    if (it < P0_TQ) {
      int l = it >> 8, r = it & 255, kt = r >> 4, nt = r & 15;
      ph0_transpose(p.peer_wq + (size_t)l * 1024 * 1024, (u16*)(p.ws + OFF_WTQ) + (size_t)l * 1024 * 1024, 1024, 1024, kt * 64, nt * 64, sm);
      continue;
    }
    it -= P0_TQ;
    if (it < P0_KEYS) {
      u16* d = (u16*)(p.ws + OFF_KEYS);
      for (int i = 0; i < 4; ++i) { int e = it * 1024 + i * 256 + tid; d[e] = f2bf(p.peer_keys[e]); }
      continue;
    }
    it -= P0_KEYS;
    if (it < P0_SGW) {
      u16* d = (u16*)(p.ws + OFF_WSB);
      for (int i = 0; i < 4; ++i) { int e = it * 1024 + i * 256 + tid; d[e] = f2bf(p.sg_w[e]); }
      continue;
    }
    it -= P0_SGW;
    if (it < P0_ROPE) {
      int e = it * 256 + tid;
      int pos = e >> 5, i = e & 31;
      int row = pos >> 6, col = pos & 63;
      float inv = powf(10000.0f, -(float)(i & 15) / 16.0f);
      float ang = (float)(i < 16 ? row : col) * inv;
      float s, cs;
      sincosf(ang, &s, &cs);
      float2* rt = (float2*)(p.ws + OFF_ROPE);
      rt[e] = make_float2(cs, s);
      continue;
    }
    it -= P0_ROPE;
    if (it < P0_FS) {
      int l = it >> 8, t0 = (it & 255) * 16;
      ph0_filter(p, l, LS, t0, (float*)((u16*)(p.ws + OFF_HFS) + (size_t)l * 256 * HFS_STRIDE), HFS_STRIDE, HFS_OFF, sm);
      continue;
    }
    it -= P0_FS;
    if (it < P0_FP) {
      int l = it >> 4, t0 = (it & 15) * 16;
      ph0_filter(p, l, LP, t0, (float*)((u16*)(p.ws + OFF_HFP) + (size_t)l * 256 * HFP_STRIDE), HFP_STRIDE, HFP_OFF, sm);
      continue;
    }
    it -= P0_FP;
    {
      (void)it;
    }
  }
}

__device__ __forceinline__ void phase_norm(const Params& p, int l, int which) {
  const int lane = otid() & 63, w = otid() >> 6;
  const float* g = (which == 0 ? p.norm_mix_g : p.norm_ffn_g) + l * DM;
  const float* mod = (const float*)(p.ws + OFF_MOD) + l * 3 * 6144;
  u16* hb = (u16*)(p.ws + OFF_HBUF);
  for (int it = obid(); it < TT / 4; it += gridDim.x) {
    int tok = it * 4 + w;
    const float* xr = which ? p.out + (size_t)tok * DM : x_in_row(p, l, tok);
    const float* mr = mod + mod_index(tok) * 6144 + (which ? 3 * 1024 : 0);
    float4 v[4];
    float ss = 0.f;
#pragma unroll
    for (int i = 0; i < 4; ++i) {
      v[i] = *(const float4*)(xr + lane * 4 + 256 * i);
      ss += v[i].x * v[i].x + v[i].y * v[i].y + v[i].z * v[i].z + v[i].w * v[i].w;
    }
    ss = wave_sum(ss);
    float rstd = rsqrtf(ss * (1.0f / 1024.0f) + 1e-6f);
#pragma unroll
    for (int i = 0; i < 4; ++i) {
      int k = lane * 4 + 256 * i;
      float4 gg = *(const float4*)(g + k);
      float4 sh = *(const float4*)(mr + k);
      float4 sc = *(const float4*)(mr + 1024 + k);
      float o0 = v[i].x * rstd * gg.x * (1.0f + sc.x) + sh.x;
      float o1 = v[i].y * rstd * gg.y * (1.0f + sc.y) + sh.y;
      float o2 = v[i].z * rstd * gg.z * (1.0f + sc.z) + sh.z;
      float o3 = v[i].w * rstd * gg.w * (1.0f + sc.w) + sh.w;
      uint2 o; o.x = pk2(o0, o1); o.y = pk2(o2, o3);
      *(uint2*)(hb + (size_t)tok * DM + k) = o;
    }
  }
}

template <int EPI, int N, int K, int LDC>
__device__ __forceinline__ void gemm_phase(const Params& p, int l, const u16* A, const u16* Bt, u16* C16, u16* sm) {
  const int tid = otid(), lane = tid & 63, w = tid >> 6;
  const int wm = w >> 1, wn = w & 1, hw = lane >> 5, r = lane & 31;
  u16* As = sm;
  u16* Bs = sm + 256 * 72;
  constexpr int ntn = N / 128;
  constexpr int ntiles = (TT / 256) * ntn;
  constexpr int nk = K / 64;
  for (int tile0 = obid(); tile0 < ntiles; tile0 += gridDim.x) {
    int tile = tile0;
    if ((gridDim.x & 511) == 0) {
      const int pass = tile0 / 512, b = tile0 & 511;
      const int xcd = b & 7, j = b >> 3;
      constexpr int mt_per_xcd = 64 / ntn;
      const int mt = pass * (512 / ntn) + xcd * mt_per_xcd + j / ntn;
      tile = mt * ntn + (j % ntn);
    }
    const int m0 = (tile / ntn) * 256, n0 = (tile % ntn) * 128;
    f32x16 acc[4][2];
#pragma unroll
    for (int a = 0; a < 4; ++a)
#pragma unroll
      for (int b = 0; b < 2; ++b)
#pragma unroll
        for (int e = 0; e < 16; ++e) acc[a][b][e] = 0.f;
    const int lrow = tid >> 3, lcc = tid & 7;
    const u16* Ag = A + (size_t)(m0 + lrow) * K + lcc * 8;
    const u16* Bg = Bt + (size_t)(n0 + lrow) * K + lcc * 8;
    uint4 ra0 = *(const uint4*)(Ag), ra1 = *(const uint4*)(Ag + 32 * K), ra2 = *(const uint4*)(Ag + 64 * K), ra3 = *(const uint4*)(Ag + 96 * K);
    uint4 ra4 = *(const uint4*)(Ag + 128 * K), ra5 = *(const uint4*)(Ag + 160 * K), ra6 = *(const uint4*)(Ag + 192 * K), ra7 = *(const uint4*)(Ag + 224 * K);
    uint4 rb0 = *(const uint4*)(Bg), rb1 = *(const uint4*)(Bg + 32 * K), rb2 = *(const uint4*)(Bg + 64 * K), rb3 = *(const uint4*)(Bg + 96 * K);
    u16* Aw = As + lrow * 72 + lcc * 8;
    u16* Bw = Bs + lrow * 72 + lcc * 8;
    const u16* Ar = As + (wm * 128 + r) * 72 + hw * 8;
    const u16* Br = Bs + (wn * 64 + r) * 72 + hw * 8;
    for (int kt = 0; kt < nk; ++kt) {
      __syncthreads();
      *(uint4*)(Aw) = ra0; *(uint4*)(Aw + 32 * 72) = ra1; *(uint4*)(Aw + 64 * 72) = ra2; *(uint4*)(Aw + 96 * 72) = ra3;
      *(uint4*)(Aw + 128 * 72) = ra4; *(uint4*)(Aw + 160 * 72) = ra5; *(uint4*)(Aw + 192 * 72) = ra6; *(uint4*)(Aw + 224 * 72) = ra7;
      *(uint4*)(Bw) = rb0; *(uint4*)(Bw + 32 * 72) = rb1; *(uint4*)(Bw + 64 * 72) = rb2; *(uint4*)(Bw + 96 * 72) = rb3;
      __syncthreads();
      if (kt + 1 < nk) {
        const u16* Ag2 = Ag + (kt + 1) * 64;
        const u16* Bg2 = Bg + (kt + 1) * 64;
        ra0 = *(const uint4*)(Ag2); ra1 = *(const uint4*)(Ag2 + 32 * K); ra2 = *(const uint4*)(Ag2 + 64 * K); ra3 = *(const uint4*)(Ag2 + 96 * K);
        ra4 = *(const uint4*)(Ag2 + 128 * K); ra5 = *(const uint4*)(Ag2 + 160 * K); ra6 = *(const uint4*)(Ag2 + 192 * K); ra7 = *(const uint4*)(Ag2 + 224 * K);
        rb0 = *(const uint4*)(Bg2); rb1 = *(const uint4*)(Bg2 + 32 * K); rb2 = *(const uint4*)(Bg2 + 64 * K); rb3 = *(const uint4*)(Bg2 + 96 * K);
      }
#pragma unroll
      for (int ks = 0; ks < 4; ++ks) {
        bf16x8 wf0 = *(const bf16x8*)(Br + ks * 16);
        bf16x8 wf1 = *(const bf16x8*)(Br + 32 * 72 + ks * 16);
#pragma unroll
        for (int mi = 0; mi < 4; ++mi) {
          bf16x8 xf = *(const bf16x8*)(Ar + mi * 32 * 72 + ks * 16);
          acc[mi][0] = MFMA32(wf0, xf, acc[mi][0]);
          acc[mi][1] = MFMA32(wf1, xf, acc[mi][1]);
        }
      }
    }
    const int mrow = m0 + wm * 128 + r;
    const int ncol = n0 + wn * 64 + 4 * hw;
    if (EPI == 0) {
      __syncthreads();
      u16* Cs = sm + w * (64 * 72);
#pragma unroll
      for (int rnd = 0; rnd < 2; ++rnd) {
#pragma unroll
        for (int ml = 0; ml < 2; ++ml) {
          const int mi = rnd * 2 + ml;
#pragma unroll
          for (int ni = 0; ni < 2; ++ni)
#pragma unroll
            for (int g = 0; g < 4; ++g) {
              uint2 o;
              o.x = pk2(acc[mi][ni][g * 4 + 0], acc[mi][ni][g * 4 + 1]);
              o.y = pk2(acc[mi][ni][g * 4 + 2], acc[mi][ni][g * 4 + 3]);
              *(uint2*)(Cs + (ml * 32 + r) * 72 + ni * 32 + g * 8 + 4 * hw) = o;
            }
        }
        u16* cg = C16 + (size_t)(m0 + wm * 128 + rnd * 64) * LDC + n0 + wn * 64;
#pragma unroll
        for (int i = 0; i < 8; ++i) {
          const int id = lane + 64 * i, row = id >> 3, cc = id & 7;
          *(uint4*)(cg + (size_t)row * LDC + cc * 8) = *(const uint4*)(Cs + row * 72 + cc * 8);
        }
      }
    } else {
      __syncthreads();
      float* Cf = (float*)sm + w * (32 * 68);
      const int cc = lane & 15;
      const float4 gm = *(const float4*)((const float*)(p.ws + OFF_MOD) + l * 3 * 6144 + mod_index(m0) * 6144 + 2 * 1024 + n0 + wn * 64 + cc * 4);
#pragma unroll
      for (int mi = 0; mi < 4; ++mi) {
#pragma unroll
        for (int ni = 0; ni < 2; ++ni)
#pragma unroll
          for (int g = 0; g < 4; ++g)
            *(float4*)(Cf + r * 68 + ni * 32 + g * 8 + 4 * hw) =
                make_float4(acc[mi][ni][g * 4 + 0], acc[mi][ni][g * 4 + 1], acc[mi][ni][g * 4 + 2], acc[mi][ni][g * 4 + 3]);
#pragma unroll
        for (int i = 0; i < 8; ++i) {
          const int row = (lane >> 4) + 4 * i;
          const int grow = m0 + wm * 128 + mi * 32 + row;
          const int gcol = n0 + wn * 64 + cc * 4;
          const float4 av = *(const float4*)(Cf + row * 68 + cc * 4);
          float4 xv = *(const float4*)(x_in_row(p, l, grow) + gcol);
          xv.x += gm.x * av.x; xv.y += gm.y * av.y; xv.z += gm.z * av.z; xv.w += gm.w * av.w;
          *(float4*)(p.out + (size_t)grow * DM + gcol) = xv;
        }
      }
    }
  }
}

__device__ __forceinline__ void prep_qkv_item(const Params& p, int l, int it, u16* sm) {
  const int tid = otid();
  const int t0 = it * 64;
  const bool samp = t0 >= TP;
  const u16* proj = (const u16*)(p.ws + OFF_PROJ);
  u16* qn = (u16*)(p.ws + OFF_QN);
  int seq, pos0;
  if (!samp) { seq = t0 >> 8; pos0 = t0 & 255; } else { seq = (t0 - TP) >> 12; pos0 = (t0 - TP) & 4095; }
  const float2* rope = (const float2*)(p.ws + OFF_ROPE);
  float* ck_out = p.out + (size_t)TT * DM;
  float* cv_out = ck_out + (size_t)32 * 2 * 256 * 128;
  unsigned* lk = (unsigned*)(sm + 16384);
  if (tid < 2) lk[tid] = 0u;
  __syncthreads();
  for (int unit = tid; unit < 640; unit += 256) {
    int tl = unit / 10, hh = unit % 10;
    int tok = t0 + tl, pos = pos0 + tl;
    const u16* src = proj + (size_t)tok * INW + hh * 64;
    float x[64];
    float ss = 0.f;
#pragma unroll
    for (int c8 = 0; c8 < 8; ++c8) {
      uint4 v = *(const uint4*)(src + c8 * 8);
      unsigned wv[4] = {v.x, v.y, v.z, v.w};
#pragma unroll
      for (int j = 0; j < 4; ++j) {
        float lo = __uint_as_float(wv[j] << 16), hi = __uint_as_float(wv[j] & 0xFFFF0000u);
        x[c8 * 8 + 2 * j] = lo; x[c8 * 8 + 2 * j + 1] = hi;
        ss += lo * lo + hi * hi;
      }
    }
    float rstd = rsqrtf(ss * (1.0f / 64.0f) + 1e-6f);
    const float* g = (hh < 8 ? p.q_norm_g : p.k_norm_g) + l * 64;
#pragma unroll
    for (int i = 0; i < 64; ++i) x[i] = x[i] * rstd * g[i];
    if (hh >= 8) {
      float k2 = 0.f;
#pragma unroll
      for (int i = 0; i < 64; ++i) k2 += x[i] * x[i];
      atomicMax(lk + (hh - 8), __float_as_uint(k2));
    }
    if (hh >= 8 && !samp) {
      float* d = ck_out + (((size_t)seq * 2 + l) * 256 + pos) * 128 + (hh - 8) * 64;
#pragma unroll
      for (int i = 0; i < 16; ++i) *(float4*)(d + 4 * i) = make_float4(x[4 * i], x[4 * i + 1], x[4 * i + 2], x[4 * i + 3]);
    }
    if (samp) {
#pragma unroll
      for (int i = 0; i < 32; ++i) {
        float2 cs = rope[pos * 32 + i];
        float a = x[2 * i], b = x[2 * i + 1];
        x[2 * i] = a * cs.x - b * cs.y;
        x[2 * i + 1] = a * cs.y + b * cs.x;
      }
    }
    u16* dst;
    float scl = 1.0f;
    if (hh < 8) { dst = qn + (size_t)tok * 512 + hh * 64; scl = 0.125f * 1.4426950408889634f; }
    else if (!samp) dst = (u16*)(p.ws + OFF_KP) + (((size_t)seq * 2 + (hh - 8)) * 256 + pos) * 64;
    else dst = (u16*)(p.ws + OFF_KS) + (((size_t)seq * 2 + (hh - 8)) * NKS + 256 + pos) * 64;
#pragma unroll
    for (int c8 = 0; c8 < 8; ++c8) {
      uint4 o;
      o.x = pk2(x[c8 * 8 + 0] * scl, x[c8 * 8 + 1] * scl);
      o.y = pk2(x[c8 * 8 + 2] * scl, x[c8 * 8 + 3] * scl);
      o.z = pk2(x[c8 * 8 + 4] * scl, x[c8 * 8 + 5] * scl);
      o.w = pk2(x[c8 * 8 + 6] * scl, x[c8 * 8 + 7] * scl);
      *(uint4*)(dst + c8 * 8) = o;
    }
  }
  u16* vt = sm;
#pragma unroll
  for (int i = 0; i < 4; ++i) {
    const int id = tid + 256 * i, tl = id >> 4, c8 = (id & 15) * 8;
    const uint4 hv = *(const uint4*)(proj + (size_t)(t0 + tl) * INW + 640 + c8);
    const unsigned wv[4] = {hv.x, hv.y, hv.z, hv.w};
#pragma unroll
    for (int j = 0; j < 4; ++j) {
      vt[(c8 + 2 * j) * 72 + tl] = (u16)(wv[j] & 0xFFFFu);
      vt[(c8 + 2 * j + 1) * 72 + tl] = (u16)(wv[j] >> 16);
    }
    if (!samp) {
      float* d = cv_out + (((size_t)seq * 2 + l) * 256 + pos0 + tl) * 128 + c8;
      *(float4*)(d) = make_float4(__uint_as_float(wv[0] << 16), __uint_as_float(wv[0] & 0xFFFF0000u), __uint_as_float(wv[1] << 16), __uint_as_float(wv[1] & 0xFFFF0000u));
      *(float4*)(d + 4) = make_float4(__uint_as_float(wv[2] << 16), __uint_as_float(wv[2] & 0xFFFF0000u), __uint_as_float(wv[3] << 16), __uint_as_float(wv[3] & 0xFFFF0000u));
    }
  }
  __syncthreads();
  if (tid < 2) atomicMax((unsigned*)(p.ws + OFF_KMAX) + (l * 34 + (samp ? 32 + seq : seq)) * 2 + tid, lk[tid]);
  {
    int rr = tid >> 1, half = tid & 1;
    int kv = rr >> 6, d = rr & 63;
    u16* dst;
    if (!samp) dst = (u16*)(p.ws + OFF_VTP) + (((size_t)seq * 2 + kv) * 64 + d) * 256 + pos0 + half * 32;
    else dst = (u16*)(p.ws + OFF_VTS) + (((size_t)seq * 2 + kv) * 64 + d) * NKS + 256 + pos0 + half * 32;
#pragma unroll
    for (int i = 0; i < 4; ++i) *(uint4*)(dst + i * 8) = *(const uint4*)(vt + rr * 72 + half * 32 + i * 8);
  }
  __syncthreads();
}

__device__ __forceinline__ void prep_cache_item(const Params& p, int l, int it, u16* sm) {
  const int tid = otid();
  int b = it >> 2, p0 = (it & 3) * 64;
  const float* ck = p.cache_k + (((size_t)b * 2 + l) * 256 + p0) * 128;
  const float* cv = p.cache_v + (((size_t)b * 2 + l) * 256 + p0) * 128;
  u16* vt = sm;
  {
    int tl = tid >> 2, part = tid & 3, kv = part >> 1, d0 = (part & 1) * 32;
    const float* src = ck + tl * 128 + kv * 64 + d0;
    u16* dst = (u16*)(p.ws + OFF_KS) + (((size_t)b * 2 + kv) * NKS + p0 + tl) * 64 + d0;
    float k2 = 0.f;
#pragma unroll
    for (int i = 0; i < 4; ++i) {
      float4 a = *(const float4*)(src + 8 * i), c4 = *(const float4*)(src + 8 * i + 4);
      k2 += a.x * a.x + a.y * a.y + a.z * a.z + a.w * a.w + c4.x * c4.x + c4.y * c4.y + c4.z * c4.z + c4.w * c4.w;
      uint4 o; o.x = pk2(a.x, a.y); o.y = pk2(a.z, a.w); o.z = pk2(c4.x, c4.y); o.w = pk2(c4.z, c4.w);
      *(uint4*)(dst + 8 * i) = o;
    }
    k2 += __shfl_xor(k2, 1);
    if ((part & 1) == 0) atomicMax((unsigned*)(p.ws + OFF_KMAX) + (l * 34 + 32 + b) * 2 + kv, __float_as_uint(k2));
  }
  for (int idx = tid; idx < 64 * 128; idx += 256) {
    int tl = idx >> 7, cc = idx & 127;
    vt[cc * 72 + tl] = f2bf(cv[idx]);
  }
  __syncthreads();
  {
    int rr = tid >> 1, half = tid & 1;
    int kv = rr >> 6, d = rr & 63;
    u16* dst = (u16*)(p.ws + OFF_VTS) + (((size_t)b * 2 + kv) * 64 + d) * NKS + p0 + half * 32;
#pragma unroll
    for (int i = 0; i < 4; ++i) *(uint4*)(dst + i * 8) = *(const uint4*)(vt + rr * 72 + half * 32 + i * 8);
  }
  __syncthreads();
}

__device__ __forceinline__ void prep_hy_item(const Params& p, int l, int it) {
  const int c = otid();
  const int t0 = it * 32;
  const u16* proj = (const u16*)(p.ws + OFF_PROJ);
  u16* ut = (u16*)(p.ws + OFF_UB) + (size_t)c * TT + t0;
  u16* xt = (u16*)(p.ws + OFF_X0) + (size_t)c * TT + t0;
  int L = t0 < TP ? LP : LS;
  int pos0 = t0 < TP ? (t0 & 255) : ((t0 - TP) & 4095);
  const float* cw = p.hy_conv_w + l * 3 * 768;
  const float* cb = p.hy_conv_b + l * 768;
  float w0[3], w1[3], w2[3], bb[3];
#pragma unroll
  for (int s = 0; s < 3; ++s) {
    w0[s] = cw[0 * 768 + s * 256 + c]; w1[s] = cw[1 * 768 + s * 256 + c]; w2[s] = cw[2 * 768 + s * 256 + c];
    bb[s] = cb[s * 256 + c];
  }
  float prev[3], cur[3], nxt[3];
#pragma unroll
  for (int s = 0; s < 3; ++s) {
    prev[s] = pos0 > 0 ? bf2f(proj[(size_t)(t0 - 1) * INW + 768 + s * 256 + c]) : 0.f;
    cur[s] = bf2f(proj[(size_t)t0 * INW + 768 + s * 256 + c]);
  }
  for (int t8 = 0; t8 < 32; t8 += 8) {
    float uv[8], xv[8];
#pragma unroll
    for (int q = 0; q < 8; ++q) {
      int tl = t8 + q;
      int tok = t0 + tl;
      bool has_next = (pos0 + tl + 1) < L;
      float z[3];
#pragma unroll
      for (int s = 0; s < 3; ++s) {
        nxt[s] = has_next ? bf2f(proj[(size_t)(tok + 1) * INW + 768 + s * 256 + c]) : 0.f;
        z[s] = prev[s] * w0[s] + cur[s] * w1[s] + nxt[s] * w2[s] + bb[s];
        prev[s] = cur[s]; cur[s] = nxt[s];
      }
      xv[q] = z[0];
      uv[q] = z[1] * z[2];
    }
    uint4 o; o.x = pk2(uv[0], uv[1]); o.y = pk2(uv[2], uv[3]); o.z = pk2(uv[4], uv[5]); o.w = pk2(uv[6], uv[7]);
    *(uint4*)(ut + t8) = o;
    o.x = pk2(xv[0], xv[1]); o.y = pk2(xv[2], xv[3]); o.z = pk2(xv[4], xv[5]); o.w = pk2(xv[6], xv[7]);
    *(uint4*)(xt + t8) = o;
  }
}

__device__ __forceinline__ void prep_sg_item(const Params& p, int l, int it) {
  const int lane = otid() & 63, w = otid() >> 6;
  const int tok0 = it * 16 + w * 4;
  const u16* src = (const u16*)(p.ws + OFF_PROJ) + (size_t)tok0 * INW + 1536;
  uint2 uu[4], vv[4];
#pragma unroll
  for (int q = 0; q < 4; ++q) {
    uu[q] = *(const uint2*)(src + (size_t)q * INW + lane * 4);
    vv[q] = *(const uint2*)(src + (size_t)q * INW + 256 + lane * 4);
  }
  const float* g = p.sg_norm_g + l * 256 + lane * 4;
  const float4 gq = *(const float4*)g;
#pragma unroll
  for (int q = 0; q < 4; ++q) {
    float u[4] = {__uint_as_float(uu[q].x << 16), __uint_as_float(uu[q].x & 0xFFFF0000u), __uint_as_float(uu[q].y << 16), __uint_as_float(uu[q].y & 0xFFFF0000u)};
    float v[4] = {__uint_as_float(vv[q].x << 16), __uint_as_float(vv[q].x & 0xFFFF0000u), __uint_as_float(vv[q].y << 16), __uint_as_float(vv[q].y & 0xFFFF0000u)};
    float ss = 0.f;
#pragma unroll
    for (int i = 0; i < 4; ++i) { u[i] = gelu_t(u[i]); v[i] = gelu_t(v[i]); ss += v[i] * v[i]; }
    ss = wave_sum(ss);
    float rstd = rsqrtf(ss * (1.0f / 256.0f) + 1e-6f);
    uint2 ou, ov;
    ou.x = pk2(u[0], u[1]); ou.y = pk2(u[2], u[3]);
    ov.x = pk2(v[0] * rstd * gq.x, v[1] * rstd * gq.y); ov.y = pk2(v[2] * rstd * gq.z, v[3] * rstd * gq.w);
    *(uint2*)((u16*)(p.ws + OFF_UG) + (size_t)(tok0 + q) * 256 + lane * 4) = ou;
    *(uint2*)((u16*)(p.ws + OFF_VGN) + (size_t)(tok0 + q) * 256 + lane * 4) = ov;
  }
}

constexpr int P3_QKV = 256, P3_CACHE = 8, P3_HY = 512, P3_SG = 1024;
__device__ __forceinline__ void phase_prep(const Params& p, int l, u16* sm) {
  const int total = P3_QKV + P3_CACHE + P3_HY + P3_SG;
  for (int it0 = obid(); it0 < total; it0 += gridDim.x) {
    int it = it0;
    if (it < P3_QKV) { prep_qkv_item(p, l, it, sm); continue; }
    it -= P3_QKV;
    if (it < P3_CACHE) { prep_cache_item(p, l, it, sm); continue; }
    it -= P3_CACHE;
    if (it < P3_HY) { prep_hy_item(p, l, it); continue; }
    it -= P3_HY;
    prep_sg_item(p, l, it);
  }
}

__device__ __forceinline__ void attn_tile(const u16* Ksb, const u16* Vsb, const u16* Qs, const float (&negm)[2], f32x16 (&o)[2][2],
                                          f32x2 (&ls2)[2], int r, int hw) {
  f32x16 s[2][2];
#pragma unroll
  for (int qt = 0; qt < 2; ++qt)
#pragma unroll
    for (int e = 0; e < 16; ++e) { s[qt][0][e] = negm[qt]; s[qt][1][e] = negm[qt]; }
#pragma unroll
  for (int ks = 0; ks < 4; ++ks) {
    bf16x8 k0 = *(const bf16x8*)(Ksb + r * 72 + ks * 16 + hw * 8);
    bf16x8 k1 = *(const bf16x8*)(Ksb + (32 + r) * 72 + ks * 16 + hw * 8);
    bf16x8 q0 = *(const bf16x8*)(Qs + r * 72 + ks * 16 + hw * 8);
    bf16x8 q1 = *(const bf16x8*)(Qs + (32 + r) * 72 + ks * 16 + hw * 8);
    s[0][0] = MFMA32(k0, q0, s[0][0]);
    s[1][0] = MFMA32(k0, q1, s[1][0]);
    s[0][1] = MFMA32(k1, q0, s[0][1]);
    s[1][1] = MFMA32(k1, q1, s[1][1]);
  }
#pragma unroll
  for (int qt = 0; qt < 2; ++qt) {
#pragma unroll
    for (int e = 0; e < 16; ++e) {
      s[qt][0][e] = __builtin_amdgcn_exp2f(s[qt][0][e]);
      s[qt][1][e] = __builtin_amdgcn_exp2f(s[qt][1][e]);
    }
#pragma unroll
    for (int e = 0; e < 16; e += 2) {
      ls2[qt] += (f32x2){s[qt][0][e], s[qt][0][e + 1]};
      ls2[qt] += (f32x2){s[qt][1][e], s[qt][1][e + 1]};
    }
  }
#pragma unroll
  for (int j = 0; j < 4; ++j) {
    const int mt = j >> 1, rb = (j & 1) * 8;
    union { bf16x8 v; unsigned u[4]; } pb0, pb1;
#pragma unroll
    for (int q = 0; q < 4; ++q) {
      pb0.u[q] = pk2(s[0][mt][rb + 2 * q], s[0][mt][rb + 2 * q + 1]);
      pb1.u[q] = pk2(s[1][mt][rb + 2 * q], s[1][mt][rb + 2 * q + 1]);
    }
#pragma unroll
    for (int dt = 0; dt < 2; ++dt) {
      union { bf16x8 v; uint2 h[2]; } va;
      const u16* vp = Vsb + (dt * 32 + r) * 72 + j * 16 + hw * 4;
      va.h[0] = *(const uint2*)(vp);
      va.h[1] = *(const uint2*)(vp + 8);
      o[0][dt] = MFMA32(va.v, pb0.v, o[0][dt]);
      o[1][dt] = MFMA32(va.v, pb1.v, o[1][dt]);
    }
  }
}

__device__ __forceinline__ void attn_item(const u16* qbase  , const u16* K, const u16* Vt, int ldv, int nk,
                          float kmax2  , u16* obase  , u16* sm) {
  const int tid = otid(), lane = tid & 63, w = tid >> 6, hw = lane >> 5, r = lane & 31;
  u16* Ks = sm;
  u16* Vs = sm + 64 * 72;
  u16* Qs = sm + 2 * 64 * 72 + w * (64 * 72);
  const int nt = nk / 64;
  const int lrow = tid >> 3, lcc = tid & 7;
  const u16* Kg = K + (size_t)lrow * 64 + lcc * 8;
  const u16* Vg = Vt + (size_t)lrow * ldv + lcc * 8;
  uint4 rk0 = *(const uint4*)(Kg), rk1 = *(const uint4*)(Kg + 32 * 64);
  uint4 rv0 = *(const uint4*)(Vg), rv1 = *(const uint4*)(Vg + (size_t)32 * ldv);
#pragma unroll
  for (int i = 0; i < 8; ++i) {
    const int id = lane + 64 * i, row = id >> 3, cc = id & 7;
    *(uint4*)(Qs + row * 72 + cc * 8) = *(const uint4*)(qbase + (size_t)(w * 64 + row) * 512 + cc * 8);
  }
  __syncthreads();
  float negm[2];
#pragma unroll
  for (int qt = 0; qt < 2; ++qt) {
    float q2 = 0.f;
#pragma unroll
    for (int ks = 0; ks < 4; ++ks) {
      bf16x8 qv8 = *(const bf16x8*)(Qs + (qt * 32 + r) * 72 + ks * 16 + hw * 8);
#pragma unroll
      for (int j = 0; j < 8; ++j) { float qv = bf2f((u16)qv8[j]); q2 += qv * qv; }
    }
    q2 += __shfl_xor(q2, 32);
    negm[qt] = -sqrtf(q2 * kmax2) * 1.004f;
  }
  f32x16 o[2][2];
#pragma unroll
  for (int e = 0; e < 16; ++e) { o[0][0][e] = 0.f; o[0][1][e] = 0.f; o[1][0][e] = 0.f; o[1][1][e] = 0.f; }
  f32x2 ls2[2] = {{0.f, 0.f}, {0.f, 0.f}};
  u16* Kw = Ks + lrow * 72 + lcc * 8;
  u16* Vw = Vs + lrow * 72 + lcc * 8;
  for (int kt = 0; kt < nt; ++kt) {
    __syncthreads();
    *(uint4*)(Kw) = rk0; *(uint4*)(Kw + 32 * 72) = rk1;
    *(uint4*)(Vw) = rv0; *(uint4*)(Vw + 32 * 72) = rv1;
    __syncthreads();
    if (kt + 1 < nt) {
      const u16* Kg2 = Kg + (size_t)(kt + 1) * 64 * 64;
      const u16* Vg2 = Vg + (kt + 1) * 64;
      rk0 = *(const uint4*)(Kg2); rk1 = *(const uint4*)(Kg2 + 32 * 64);
      rv0 = *(const uint4*)(Vg2); rv1 = *(const uint4*)(Vg2 + (size_t)32 * ldv);
    }
    attn_tile(Ks, Vs, Qs, negm, o, ls2, r, hw);
  }
#pragma unroll
  for (int qt = 0; qt < 2; ++qt) {
    float lsum = ls2[qt][0] + ls2[qt][1];
    float lt = lsum + __shfl_xor(lsum, 32);
    float inv = 1.0f / lt;
    u16* orow = obase + (size_t)(w * 64 + qt * 32 + r) * DM;
#pragma unroll
    for (int dt = 0; dt < 2; ++dt)
#pragma unroll
      for (int rg = 0; rg < 4; ++rg) {
        uint2 ov;
        ov.x = pk2(o[qt][dt][rg * 4 + 0] * inv, o[qt][dt][rg * 4 + 1] * inv);
        ov.y = pk2(o[qt][dt][rg * 4 + 2] * inv, o[qt][dt][rg * 4 + 3] * inv);
        *(uint2*)(orow + dt * 32 + rg * 8 + hw * 4) = ov;
      }
  }
  __syncthreads();
}

__device__ __forceinline__ void hy_sample_item(const Params& p, int l, int c, float* smf) {
  const int tid = otid(), lane = tid & 63, w = tid >> 6;
  u16* R = (u16*)smf;
  u16* U = R + 8208;
  const u16* hf = (const u16*)(p.ws + OFF_HFS) + ((size_t)l * 256 + c) * HFS_STRIDE;
  for (int i = tid; i < 8208 / 8; i += 256) *(uint4*)(R + i * 8) = *(const uint4*)(hf + i * 8);
  const u16* utb = (const u16*)(p.ws + OFF_UB) + (size_t)c * TT + TP;
  for (int i = tid; i < 2 * 522; i += 256) {
    int b = i / 522, q = i % 522;
    int s = q * 8 - 32;
    uint4 v = make_uint4(0u, 0u, 0u, 0u);
    if (s >= 0 && s < 4096) v = *(const uint4*)(utb + b * 4096 + s);
    *(uint4*)(U + b * 4176 + q * 8) = v;
  }
  __syncthreads();
  const int n = lane & 15, kq = lane >> 4;
  f32x4 acc[4][2];
#pragma unroll
  for (int ii = 0; ii < 4; ++ii)
#pragma unroll
    for (int b = 0; b < 2; ++b) acc[ii][b] = (f32x4){0.f, 0.f, 0.f, 0.f};
  const u16* Ra = R + 4112 - 256 * (4 * w) - 16 * n + 8 * kq;
  const u16* Ub0 = U + 32 + 8 * kq + n;
  for (int s0 = -32; s0 <= 4064; s0 += 32) {
    union { bf16x8 v; unsigned u[4]; } b0, b1;
    const u16* up = Ub0 + s0;
#pragma unroll
    for (int j = 0; j < 4; ++j) {
      b0.u[j] = (unsigned)up[2 * j] | ((unsigned)up[2 * j + 1] << 16);
      b1.u[j] = (unsigned)up[4176 + 2 * j] | ((unsigned)up[4176 + 2 * j + 1] << 16);
    }
#pragma unroll
    for (int ii = 0; ii < 4; ++ii) {
      bf16x8 a = *(const bf16x8*)(Ra + s0 - 256 * ii);
      acc[ii][0] = __builtin_amdgcn_mfma_f32_16x16x32_bf16(a, b0.v, acc[ii][0], 0, 0, 0);
      acc[ii][1] = __builtin_amdgcn_mfma_f32_16x16x32_bf16(a, b1.v, acc[ii][1], 0, 0, 0);
    }
  }
  float skip = p.hy_skip[l * 256 + c];
  const u16* xt = (const u16*)(p.ws + OFF_X0) + (size_t)c * TT + TP;
  u16* mix = (u16*)(p.ws + OFF_MIX);
#pragma unroll
  for (int ii = 0; ii < 4; ++ii)
#pragma unroll
    for (int b = 0; b < 2; ++b)
#pragma unroll
      for (int r = 0; r < 4; ++r) {
        int t = 256 * (4 * w + ii) + 16 * (4 * kq + r) + n;
        size_t tok = (size_t)TP + b * LS + t;
        float y = bf2f(xt[b * LS + t]) * (acc[ii][b][r] + bf2f(U[b * 4176 + 32 + t]) * skip);
        mix[tok * DM + 512 + c] = f2bf(y);
      }
  __syncthreads();
}

__device__ __forceinline__ void hy_prompt_item(const Params& p, int l, int c, float* smf) {
  const int tid = otid(), lane = tid & 63, w = tid >> 6;
  u16* R = (u16*)smf;
  u16* U = R + 544;
  const u16* hf = (const u16*)(p.ws + OFF_HFP) + ((size_t)l * 256 + c) * HFP_STRIDE;
  if (tid < 528 / 8) *(uint4*)(R + tid * 8) = *(const uint4*)(hf + tid * 8);
  const u16* ut = (const u16*)(p.ws + OFF_UB) + (size_t)c * TT;
  for (int i = tid; i < 32 * 42; i += 256) {
    int b = i / 42, q = i % 42;
    int s = q * 8 - 32;
    uint4 v = make_uint4(0u, 0u, 0u, 0u);
    if (s >= 0 && s < 256) v = *(const uint4*)(ut + b * 256 + s);
    *(uint4*)(U + b * 336 + q * 8) = v;
  }
  __syncthreads();
  const int n = lane & 15, kq = lane >> 4;
  bf16x8 af[9];
#pragma unroll
  for (int j = 0; j < 9; ++j) af[j] = *(const bf16x8*)(R + 272 + (-32 + 32 * j) - 16 * n + 8 * kq);
  float skip = p.hy_skip[l * 256 + c];
  const u16* xt = (const u16*)(p.ws + OFF_X0) + (size_t)c * TT;
  u16* mix = (u16*)(p.ws + OFF_MIX);
  for (int bb = 0; bb < 8; ++bb) {
    const int b = w * 8 + bb;
    f32x4 acc = {0.f, 0.f, 0.f, 0.f};
    const u16* ub0 = U + b * 336 + 8 * kq + n;
#pragma unroll
    for (int j = 0; j < 9; ++j) {
      const u16* up = ub0 + 32 * j;
      union { bf16x8 v; unsigned u[4]; } bf;
#pragma unroll
      for (int q = 0; q < 4; ++q) bf.u[q] = (unsigned)up[2 * q] | ((unsigned)up[2 * q + 1] << 16);
      acc = __builtin_amdgcn_mfma_f32_16x16x32_bf16(af[j], bf.v, acc, 0, 0, 0);
    }
#pragma unroll
    for (int r = 0; r < 4; ++r) {
      int t = 16 * (4 * kq + r) + n;
      size_t tok = (size_t)b * 256 + t;
      float y = bf2f(xt[tok]) * (acc[r] + bf2f(U[b * 336 + 32 + t]) * skip);
      mix[tok * DM + 512 + c] = f2bf(y);
    }
  }
  __syncthreads();
}

__device__ __forceinline__ void sg_item(const Params& p, int l, int it, u16* sm) {
  const int tid = otid(), lane = tid & 63, w = tid >> 6, hw = lane >> 5, r = lane & 31;
  const int chunk = it >> 2, h = it & 3;
  const int tok0 = chunk * 128;
  u16* Bs = sm;
  const u16* vgn = (const u16*)(p.ws + OFF_VGN);
#pragma unroll
  for (int i = 0; i < 4; ++i) {
    int id = tid + 256 * i, q = id >> 3, cc = id & 7;
    uint4 v = *(const uint4*)(vgn + (size_t)(tok0 + q) * 256 + h * 64 + cc * 8);
    unsigned wv[4] = {v.x, v.y, v.z, v.w};
#pragma unroll
    for (int j = 0; j < 4; ++j) {
      Bs[(cc * 8 + 2 * j) * 136 + q] = (u16)(wv[j] & 0xFFFFu);
      Bs[(cc * 8 + 2 * j + 1) * 136 + q] = (u16)(wv[j] >> 16);
    }
  }
  __syncthreads();
  const u16* wsb = (const u16*)(p.ws + OFF_WSB) + ((size_t)(l * 4 + h) * 128) * 128;
  f32x16 acc[2];
#pragma unroll
  for (int e = 0; e < 16; ++e) { acc[0][e] = 0.f; acc[1][e] = 0.f; }
#pragma unroll
  for (int ks = 0; ks < 8; ++ks) {
    bf16x8 a = *(const bf16x8*)(wsb + (size_t)(w * 32 + r) * 128 + ks * 16 + hw * 8);
    bf16x8 b0 = *(const bf16x8*)(Bs + r * 136 + ks * 16 + hw * 8);
    bf16x8 b1 = *(const bf16x8*)(Bs + (32 + r) * 136 + ks * 16 + hw * 8);
    acc[0] = MFMA32(a, b0, acc[0]);
    acc[1] = MFMA32(a, b1, acc[1]);
  }
  const u16* ug = (const u16*)(p.ws + OFF_UG);
  u16* mix = (u16*)(p.ws + OFF_MIX);
  const float* sb = p.sg_b + (l * 4 + h) * 128;
#pragma unroll
  for (int nt = 0; nt < 2; ++nt)
#pragma unroll
    for (int e = 0; e < 16; ++e) {
      int pp = w * 32 + (e & 3) + 8 * (e >> 2) + 4 * hw;
      int cc = nt * 32 + r;
      size_t tok = (size_t)tok0 + pp;
      float val = (acc[nt][e] + sb[pp]) * bf2f(ug[tok * 256 + h * 64 + cc]);
      mix[tok * DM + 768 + h * 64 + cc] = f2bf(val);
    }
  __syncthreads();
}

__device__ __forceinline__ void tab_item(const Params& p, int it) {
  const int tid = otid();
      int tab = it >> 11, r = it & 2047;
      const float* src = (tab ? p.peer_v : p.peer_u) + (size_t)r * 16384 + tid * 16;
      unsigned char* dst = (unsigned char*)(p.ws + (tab ? OFF_VT : OFF_UT)) + (size_t)r * 16384 + tid * 16;
      const float scl = tab ? 64.0f : 256.0f;
      f32x4 f[4][4];
#pragma unroll
      for (int q = 0; q < 4; ++q)
#pragma unroll
        for (int j = 0; j < 4; ++j) f[q][j] = __builtin_nontemporal_load((const f32x4*)(src + q * 4096 + j * 4));
#pragma unroll
      for (int q = 0; q < 4; ++q) {
        unsigned ow[4];
#pragma unroll
        for (int j = 0; j < 4; ++j) {
          int t = __builtin_amdgcn_cvt_pk_fp8_f32(f[q][j][0] * scl, f[q][j][1] * scl, 0, false);
          t = __builtin_amdgcn_cvt_pk_fp8_f32(f[q][j][2] * scl, f[q][j][3] * scl, t, true);
          ow[j] = (unsigned)t;
        }
        *(uint4*)(dst + q * 4096) = make_uint4(ow[0], ow[1], ow[2], ow[3]);
      }
}

constexpr int P4_AS = 256, P4_HS = 256, P4_HP = 256, P4_AP = 256, P4_SG = 512;
__device__ __forceinline__ void phase_mix(const Params& p, int l, u16* sm) {
  const int total = P4_AS + P4_HS + P4_HP + P4_AP + P4_SG;
  if (l == 0 && (obid() & 1)) for (int it = obid(); it < P0_TAB; it += gridDim.x) tab_item(p, it);
  const u16* qn = (const u16*)(p.ws + OFF_QN);
  u16* mix = (u16*)(p.ws + OFF_MIX);
  const bool bias = (gridDim.x == 512);
  const int main_items = P4_AS + P4_HS;
  for (int step = 0; ; ++step) {
    int it0;
    if (!bias) { it0 = obid() + step * (int)gridDim.x; if (it0 >= total) break; }
    else {
      const int bid = obid();
      if (step == 0) it0 = bid;
      else if (bid >= 256) { if (step >= 3) break; it0 = main_items + (bid - 256) + (step - 1) * 256; }
      else { if (step >= 3) break; it0 = main_items + 512 + bid + (step - 1) * 256; }
    }
    int it = it0;
    if (it < P4_AS) {
      int b = it >> 7, rr = it & 127, head = rr >> 4, qb = rr & 15;
      int kv = head >> 2;
      size_t tok0 = (size_t)TP + b * LS + qb * 256;
      attn_item(qn + tok0 * 512 + head * 64, (const u16*)(p.ws + OFF_KS) + ((size_t)b * 2 + kv) * NKS * 64,
                (const u16*)(p.ws + OFF_VTS) + ((size_t)b * 2 + kv) * 64 * NKS, NKS, NKS,
                ((const float*)(p.ws + OFF_KMAX))[(l * 34 + 32 + b) * 2 + kv], mix + tok0 * DM + head * 64, sm);
      continue;
    }
    it -= P4_AS;
    if (it < P4_HS) { hy_sample_item(p, l, it, (float*)sm); continue; }
    it -= P4_HS;
    if (it < P4_HP) { hy_prompt_item(p, l, it, (float*)sm); continue; }
    it -= P4_HP;
    if (it < P4_AP) {
      int b = it >> 3, head = it & 7;
      int kv = head >> 2;
      size_t tok0 = (size_t)b * 256;
      attn_item(qn + tok0 * 512 + head * 64, (const u16*)(p.ws + OFF_KP) + ((size_t)b * 2 + kv) * 256 * 64,
                (const u16*)(p.ws + OFF_VTP) + ((size_t)b * 2 + kv) * 64 * 256, 256, 256,
                ((const float*)(p.ws + OFF_KMAX))[(l * 34 + b) * 2 + kv], mix + tok0 * DM + head * 64, sm);
      continue;
    }
    it -= P4_AP;
    sg_item(p, l, it, sm);
  }
  if (l == 0 && !(obid() & 1)) for (int it = obid(); it < P0_TAB; it += gridDim.x) tab_item(p, it);
}

__device__ __forceinline__ unsigned ordf(float f) {
  unsigned b = __float_as_uint(f);
  return (b & 0x80000000u) ? ~b : (b | 0x80000000u);
}
__device__ __forceinline__ float unordf(unsigned k) {
  unsigned b = (k & 0x80000000u) ? (k & 0x7FFFFFFFu) : ~k;
  return __uint_as_float(b);
}
__device__ __forceinline__ void sort16_desc(unsigned (&a)[16]) {
#pragma unroll
  for (int k = 2; k <= 16; k <<= 1) {
#pragma unroll
    for (int j = k >> 1; j > 0; j >>= 1) {
#pragma unroll
      for (int i = 0; i < 16; ++i) {
        int l2 = i ^ j;
        if (l2 > i) {
          bool desc = ((i & k) == 0);
          unsigned x = a[i], y = a[l2];
          unsigned mx = max(x, y), mn = min(x, y);
          a[i] = desc ? mx : mn;
          a[l2] = desc ? mn : mx;
        }
      }
    }
  }
}
__device__ __forceinline__ void merge16_desc(unsigned (&a)[16]) {
#pragma unroll
  for (int j = 8; j > 0; j >>= 1) {
#pragma unroll
    for (int i = 0; i < 16; ++i) {
      int l2 = i ^ j;
      if (l2 > i) {
        unsigned x = a[i], y = a[l2];
        a[i] = max(x, y);
        a[l2] = min(x, y);
      }
    }
  }
}
__device__ __forceinline__ void top16_of_64(const unsigned (&in)[64], unsigned (&T)[16]) {
#pragma unroll
  for (int ch = 0; ch < 4; ++ch) {
    unsigned C[16];
#pragma unroll
    for (int i = 0; i < 16; ++i) C[i] = in[ch * 16 + i];
    sort16_desc(C);
    if (ch == 0) {
#pragma unroll
      for (int i = 0; i < 16; ++i) T[i] = C[i];
    } else {
#pragma unroll
      for (int i = 0; i < 16; ++i) T[i] = max(T[i], C[15 - i]);
      merge16_desc(T);
    }
  }
}

__device__ __forceinline__ void peer_load8(const int* ip, const unsigned char* ut, const unsigned char* vtb, int lane, uint4 (&uu)[8], uint4 (&vv)[8]) {
#pragma unroll
  for (int j = 0; j < 8; ++j) {
    int idx = ip[j];
    uu[j] = *(const uint4*)(ut + (size_t)idx * 1024 + lane * 16);
    vv[j] = *(const uint4*)(vtb + (size_t)idx * 1024 + lane * 16);
  }
}
__device__ __forceinline__ void peer_compute8(const uint4 (&uu)[8], const uint4 (&vv)[8], const f32x2 (&x2)[8], f32x2 (&o2)[8], float gate_me, int lane) {
  float pd[8];
#pragma unroll
  for (int j = 0; j < 8; ++j) {
    unsigned uw[4] = {uu[j].x, uu[j].y, uu[j].z, uu[j].w};
    f32x2 d2 = {0.f, 0.f};
#pragma unroll
    for (int k = 0; k < 4; ++k) {
      f32x2 lo = __builtin_amdgcn_cvt_pk_f32_fp8((int)uw[k], false);
      f32x2 hi = __builtin_amdgcn_cvt_pk_f32_fp8((int)uw[k], true);
      d2 = __builtin_elementwise_fma(lo, x2[2 * k], d2);
      d2 = __builtin_elementwise_fma(hi, x2[2 * k + 1], d2);
    }
    pd[j] = d2[0] + d2[1];
  }
  float q4[4], q2[2], q1;
#pragma unroll
  for (int j = 0; j < 4; ++j) {
    float mine = (lane & 32) ? pd[j + 4] : pd[j];
    float oth = (lane & 32) ? pd[j] : pd[j + 4];
    q4[j] = mine + __shfl_xor(oth, 32);
  }
#pragma unroll
  for (int j = 0; j < 2; ++j) {
    float mine = (lane & 16) ? q4[j + 2] : q4[j];
    float oth = (lane & 16) ? q4[j] : q4[j + 2];
    q2[j] = mine + __shfl_xor(oth, 16);
  }
  {
    float mine = (lane & 8) ? q2[1] : q2[0];
    float oth = (lane & 8) ? q2[0] : q2[1];
    q1 = mine + __shfl_xor(oth, 8);
  }
  q1 += __shfl_xor(q1, 4); q1 += __shfl_xor(q1, 2); q1 += __shfl_xor(q1, 1);
  float a = gelu_t(q1 * (1.0f / 256.0f)) * gate_me * (1.0f / 64.0f);
#pragma unroll
  for (int j = 0; j < 8; ++j) {
    const int src_lane = (j >> 2) * 32 + ((j >> 1) & 1) * 16 + (j & 1) * 8;
    float aj = __uint_as_float((unsigned)__builtin_amdgcn_readlane((int)__float_as_uint(a), src_lane));
    unsigned vw[4] = {vv[j].x, vv[j].y, vv[j].z, vv[j].w};
    f32x2 aj2 = {aj, aj};
#pragma unroll
    for (int k = 0; k < 4; ++k) {
      f32x2 lo = __builtin_amdgcn_cvt_pk_f32_fp8((int)vw[k], false);
      f32x2 hi = __builtin_amdgcn_cvt_pk_f32_fp8((int)vw[k], true);
      o2[2 * k] = __builtin_elementwise_fma(aj2, lo, o2[2 * k]);
      o2[2 * k + 1] = __builtin_elementwise_fma(aj2, hi, o2[2 * k + 1]);
    }
  }
}

__device__ __forceinline__ void peer_item(const Params& p, int l, int it, u16* smraw) {
  const int tid = otid(), lane = tid & 63, w = tid >> 6, hw = lane >> 5, r = lane & 31;
  const int t0 = it * 32;
  int* sidx = (int*)smraw;
  float* sgate = (float*)(smraw) + 32 * 128;
  const u16* qp = (const u16*)(p.ws + OFF_QP);
  const u16* keysb = (const u16*)(p.ws + OFF_KEYS);
  for (int hh = 0; hh < 2; ++hh) {
    const int h = w * 2 + hh;
    unsigned P[2][16];
#pragma unroll
    for (int pp = 0; pp < 2; ++pp) {
      f32x16 acc[4];
#pragma unroll
      for (int mt = 0; mt < 4; ++mt)
#pragma unroll
        for (int e = 0; e < 16; ++e) acc[mt][e] = 0.f;
      const u16* kb = keysb + ((size_t)((l * 8 + h) * 2 + pp) * 128) * 64;
      const u16* qb = qp + (size_t)(t0 + r) * 1024 + h * 128 + pp * 64;
#pragma unroll
      for (int ks = 0; ks < 4; ++ks) {
        bf16x8 b = *(const bf16x8*)(qb + ks * 16 + hw * 8);
#pragma unroll
        for (int mt = 0; mt < 4; ++mt) {
          bf16x8 a = *(const bf16x8*)(kb + (size_t)(mt * 32 + r) * 64 + ks * 16 + hw * 8);
          acc[mt] = MFMA32(a, b, acc[mt]);
        }
      }
      unsigned in[64];
#pragma unroll
      for (int mt = 0; mt < 4; ++mt)
#pragma unroll
        for (int e = 0; e < 16; ++e) {
          unsigned n = 32 * mt + (e & 3) + 8 * (e >> 2) + 4 * hw;
          in[mt * 16 + e] = (ordf(acc[mt][e]) & ~127u) | n;
        }
      unsigned T[16];
      top16_of_64(in, T);
      unsigned C[16];
#pragma unroll
      for (int i = 0; i < 16; ++i) C[i] = (unsigned)__shfl_xor((int)T[15 - i], 32);
#pragma unroll
      for (int i = 0; i < 16; ++i) T[i] = max(T[i], C[i]);
      merge16_desc(T);
#pragma unroll
      for (int i = 0; i < 16; ++i) P[pp][i] = T[i];
    }
    float v1[16], v2[16];
#pragma unroll
    for (int i = 0; i < 16; ++i) {
      v1[i] = unordf((P[0][i] & ~127u) | 64u);
      v2[i] = unordf((P[1][i] & ~127u) | 64u);
    }
    unsigned cd[64];
    {
      int n = 0;
#pragma unroll
      for (int a = 0; a < 16; ++a)
#pragma unroll
        for (int b = 0; b < 16; ++b)
          if ((a + 1) * (b + 1) <= 16) {
            cd[n] = (ordf(v1[a] + v2[b]) & ~255u) | (unsigned)(a * 16 + b);
            ++n;
          }
#pragma unroll
      for (int k = 50; k < 64; ++k) cd[k] = 0u;
    }
    unsigned T[16];
    {
#pragma unroll
      for (int ch = 0; ch < 3; ++ch) {
        unsigned C[16];
#pragma unroll
        for (int i = 0; i < 16; ++i) C[i] = cd[ch * 16 + i];
        sort16_desc(C);
        if (ch == 0) {
#pragma unroll
          for (int i = 0; i < 16; ++i) T[i] = C[i];
        } else {
#pragma unroll
          for (int i = 0; i < 16; ++i) T[i] = max(T[i], C[15 - i]);
          merge16_desc(T);
        }
      }
      const unsigned hi2 = max(cd[48], cd[49]), lo2 = min(cd[48], cd[49]);
      T[15] = max(T[15], hi2);
      T[14] = max(T[14], lo2);
      merge16_desc(T);
    }
    float sc[16];
    float mxv;
#pragma unroll
    for (int i = 0; i < 16; ++i) sc[i] = unordf((T[i] & ~255u) | 128u);
    mxv = sc[0];
    float sum = 0.f;
#pragma unroll
    for (int i = 0; i < 16; ++i) { sc[i] = __expf(sc[i] - mxv); sum += sc[i]; }
    float inv = 1.0f / sum;
    if (hw == 0) {
      unsigned pka[4], pkb[4];
#pragma unroll
      for (int q = 0; q < 4; ++q) {
        pka[q] = (P[0][4 * q] & 127u) | ((P[0][4 * q + 1] & 127u) << 8) | ((P[0][4 * q + 2] & 127u) << 16) | ((P[0][4 * q + 3] & 127u) << 24);
        pkb[q] = (P[1][4 * q] & 127u) | ((P[1][4 * q + 1] & 127u) << 8) | ((P[1][4 * q + 2] & 127u) << 16) | ((P[1][4 * q + 3] & 127u) << 24);
      }
#if PEER_PART
      unsigned eidx[16];
#endif
#pragma unroll
      for (int i = 0; i < 16; ++i) {
        unsigned pos = T[i] & 255u;
        unsigned a = pos >> 4, b = pos & 15u;
        const unsigned wa = (a & 8u) ? ((a & 4u) ? pka[3] : pka[2]) : ((a & 4u) ? pka[1] : pka[0]);
        const unsigned wb = (b & 8u) ? ((b & 4u) ? pkb[3] : pkb[2]) : ((b & 4u) ? pkb[1] : pkb[0]);
        const unsigned ia = (wa >> ((a & 3u) * 8u)) & 127u;
        const unsigned ib = (wb >> ((b & 3u) * 8u)) & 127u;
#if PEER_PART
        eidx[i] = ia * 128u + ib;
#else
        sidx[r * 128 + h * 16 + i] = (int)(ia * 128u + ib);
        sgate[r * 128 + h * 16 + i] = sc[i] * inv;
#endif
      }
#if PEER_PART
      u16* gi = (u16*)(p.ws + OFF_GIDX) + (size_t)(t0 + r) * 128 + h * 16;
      float* gg = (float*)(p.ws + OFF_GGATE) + (size_t)(t0 + r) * 128 + h * 16;
      *(uint4*)(gi) = make_uint4(eidx[0] | (eidx[1] << 16), eidx[2] | (eidx[3] << 16), eidx[4] | (eidx[5] << 16), eidx[6] | (eidx[7] << 16));
      *(uint4*)(gi + 8) = make_uint4(eidx[8] | (eidx[9] << 16), eidx[10] | (eidx[11] << 16), eidx[12] | (eidx[13] << 16), eidx[14] | (eidx[15] << 16));
#pragma unroll
      for (int i = 0; i < 4; ++i) *(float4*)(gg + 4 * i) = make_float4(sc[4 * i] * inv, sc[4 * i + 1] * inv, sc[4 * i + 2] * inv, sc[4 * i + 3] * inv);
#endif
    }
  }
#if PEER_PART
  return;
#endif
  __syncthreads();
  const float* mod = (const float*)(p.ws + OFF_MOD) + l * 3 * 6144;
  const u16* hb = (const u16*)(p.ws + OFF_HBUF);
  const unsigned char* ut = (const unsigned char*)(p.ws + OFF_UT) + (size_t)l * 16384 * 1024;
  const unsigned char* vtb = (const unsigned char*)(p.ws + OFF_VT) + (size_t)l * 16384 * 1024;
  const int me = ((lane >> 5) & 1) * 4 + ((lane >> 4) & 1) * 2 + ((lane >> 3) & 1);
  uint4 uA[8], vA[8], uB[8], vB[8];
  for (int tq = 0; tq < 8; ++tq) {
    const int tl = w * 8 + tq;
    const int tok = t0 + tl;
    float xr[16];
    {
      uint4 h0 = *(const uint4*)(hb + (size_t)tok * DM + lane * 16);
      uint4 h1 = *(const uint4*)(hb + (size_t)tok * DM + lane * 16 + 8);
      unsigned hw4[8] = {h0.x, h0.y, h0.z, h0.w, h1.x, h1.y, h1.z, h1.w};
#pragma unroll
      for (int j = 0; j < 8; ++j) { xr[2 * j] = __uint_as_float(hw4[j] << 16); xr[2 * j + 1] = __uint_as_float(hw4[j] & 0xFFFF0000u); }
    }
    f32x2 x2[8], o2[8];
#pragma unroll
    for (int i = 0; i < 8; ++i) { x2[i] = (f32x2){xr[2 * i], xr[2 * i + 1]}; o2[i] = (f32x2){0.f, 0.f}; }
    if (tq == 0) peer_load8(sidx + tl * 128, ut, vtb, lane, uA, vA);
    for (int g8 = 0; g8 < 16; g8 += 2) {
      peer_load8(sidx + tl * 128 + (g8 + 1) * 8, ut, vtb, lane, uB, vB);
      peer_compute8(uA, vA, x2, o2, sgate[tl * 128 + g8 * 8 + me], lane);
      if (g8 + 2 < 16) peer_load8(sidx + tl * 128 + (g8 + 2) * 8, ut, vtb, lane, uA, vA);
      else if (tq < 7) peer_load8(sidx + (tl + 1) * 128, ut, vtb, lane, uA, vA);
      peer_compute8(uB, vB, x2, o2, sgate[tl * 128 + (g8 + 1) * 8 + me], lane);
    }
    const float* gf = mod + mod_index(tok) * 6144 + 5 * 1024;
    float* orow = p.out + (size_t)tok * DM;
#pragma unroll
    for (int i = 0; i < 4; ++i) {
      int k = lane * 16 + i * 4;
      float4 xv = *(const float4*)(orow + k);
      float4 gv = *(const float4*)(gf + k);
      xv.x += gv.x * o2[i * 2][0]; xv.y += gv.y * o2[i * 2][1];
      xv.z += gv.z * o2[i * 2 + 1][0]; xv.w += gv.w * o2[i * 2 + 1][1];
      *(float4*)(orow + k) = xv;
    }
  }
  if (l == 0) {
    for (int tq = 0; tq < 8; ++tq) {
      const int tok = t0 + w * 8 + tq;
      const float* orow = p.out + (size_t)tok * DM;
      float4 xq[4];
      float ss = 0.f;
#pragma unroll
      for (int i = 0; i < 4; ++i) {
        xq[i] = *(const float4*)(orow + lane * 16 + i * 4);
        ss += xq[i].x * xq[i].x + xq[i].y * xq[i].y + xq[i].z * xq[i].z + xq[i].w * xq[i].w;
      }
      ss = wave_sum(ss);
      const float rstd = rsqrtf(ss * (1.0f / 1024.0f) + 1e-6f);
      const float* g1 = p.norm_mix_g + DM;
      const float* mr = (const float*)(p.ws + OFF_MOD) + 3 * 6144 + mod_index(tok) * 6144;
      u16* hw_ = (u16*)(p.ws + OFF_HBUF) + (size_t)tok * DM;
#pragma unroll
      for (int i = 0; i < 4; ++i) {
        int k = lane * 16 + i * 4;
        float4 gg = *(const float4*)(g1 + k);
        float4 sh = *(const float4*)(mr + k);
        float4 sc = *(const float4*)(mr + 1024 + k);
        uint2 o;
        o.x = pk2(xq[i].x * rstd * gg.x * (1.0f + sc.x) + sh.x, xq[i].y * rstd * gg.y * (1.0f + sc.y) + sh.y);
        o.y = pk2(xq[i].z * rstd * gg.z * (1.0f + sc.z) + sh.z, xq[i].w * rstd * gg.w * (1.0f + sc.w) + sh.w);
        *(uint2*)(hw_ + k) = o;
      }
    }
  }
  __syncthreads();
}


#if PEER_PART
__device__ __forceinline__ void pu_load8(const unsigned* pl, int base, int n, const unsigned char* ut, int lane, uint4 (&uu)[8], unsigned (&pr)[8]) {
#pragma unroll
  for (int j = 0; j < 8; ++j) {
    const int q = base + j;
    pr[j] = pl[q < n ? q : 0] | (q < n ? 0u : 0x80000000u);
    uu[j] = *(const uint4*)(ut + (size_t)(pr[j] & 0xFFFFu) * 1024 + lane * 16);
  }
}
__device__ __forceinline__ void pu_compute8(const uint4 (&uu)[8], const unsigned (&pr)[8], const u16* xs, const float* gs, float* abuf_tile, int lane, int me) {
  float pd[8];
#pragma unroll
  for (int j = 0; j < 8; ++j) {
    const int tl = (pr[j] >> 23) & 15;
    const uint4 xa = *(const uint4*)(xs + tl * 1024 + lane * 16);
    const uint4 xb = *(const uint4*)(xs + tl * 1024 + lane * 16 + 8);
    const unsigned xw[8] = {xa.x, xa.y, xa.z, xa.w, xb.x, xb.y, xb.z, xb.w};
    const unsigned uw[4] = {uu[j].x, uu[j].y, uu[j].z, uu[j].w};
    f32x2 d2 = {0.f, 0.f};
#pragma unroll
    for (int k = 0; k < 4; ++k) {
      f32x2 lo = __builtin_amdgcn_cvt_pk_f32_fp8((int)uw[k], false);
      f32x2 hi = __builtin_amdgcn_cvt_pk_f32_fp8((int)uw[k], true);
      f32x2 x0 = {__uint_as_float(xw[2 * k] << 16), __uint_as_float(xw[2 * k] & 0xFFFF0000u)};
      f32x2 x1 = {__uint_as_float(xw[2 * k + 1] << 16), __uint_as_float(xw[2 * k + 1] & 0xFFFF0000u)};
      d2 = __builtin_elementwise_fma(lo, x0, d2);
      d2 = __builtin_elementwise_fma(hi, x1, d2);
    }
    pd[j] = d2[0] + d2[1];
  }
  float q4[4], q2[2], q1;
#pragma unroll
  for (int j = 0; j < 4; ++j) {
    float mine = (lane & 32) ? pd[j + 4] : pd[j];
    float oth = (lane & 32) ? pd[j] : pd[j + 4];
    q4[j] = mine + __shfl_xor(oth, 32);
  }
#pragma unroll
  for (int j = 0; j < 2; ++j) {
    float mine = (lane & 16) ? q4[j + 2] : q4[j];
    float oth = (lane & 16) ? q4[j] : q4[j + 2];
    q2[j] = mine + __shfl_xor(oth, 16);
  }
  {
    float mine = (lane & 8) ? q2[1] : q2[0];
    float oth = (lane & 8) ? q2[0] : q2[1];
    q1 = mine + __shfl_xor(oth, 8);
  }
  q1 += __shfl_xor(q1, 4); q1 += __shfl_xor(q1, 2); q1 += __shfl_xor(q1, 1);
  unsigned mypr = pr[0];
#pragma unroll
  for (int j = 1; j < 8; ++j) mypr = (me == j) ? pr[j] : mypr;
  if ((lane & 7) == 0 && !(mypr & 0x80000000u)) {
    const int e = (mypr >> 16) & 2047;
    abuf_tile[e] = gelu_t(q1 * (1.0f / 256.0f)) * gs[e] * (1.0f / 64.0f);
  }
}
__device__ __forceinline__ void peer_u_unit(const Params& p, int l, int x, int tile16, u16* sm) {
  const int tid = otid(), lane = tid & 63, w = tid >> 6;
  u16* xs = sm;
  float* gs = (float*)(sm + 16384);
  unsigned* pl = (unsigned*)(sm + 20480);
  int* cnt = (int*)(sm + 24576);
  const int tok0 = tile16 * 16;
  const u16* hb = (const u16*)(p.ws + OFF_HBUF) + (size_t)tok0 * DM;
#pragma unroll
  for (int i = 0; i < 8; ++i) {
    const int ch = tid + 256 * i;
    *(uint4*)(xs + ch * 8) = *(const uint4*)(hb + ch * 8);
  }
  const float* gg = (const float*)(p.ws + OFF_GGATE) + (size_t)tok0 * 128;
#pragma unroll
  for (int i = 0; i < 2; ++i) {
    const int e = (tid + 256 * i) * 4;
    *(float4*)(gs + e) = *(const float4*)(gg + e);
  }
  if (tid == 0) *cnt = 0;
  __syncthreads();
  {
    const uint4 iv = *(const uint4*)((const u16*)(p.ws + OFF_GIDX) + (size_t)tok0 * 128 + tid * 8);
    const unsigned iw[4] = {iv.x, iv.y, iv.z, iv.w};
#pragma unroll
    for (int j = 0; j < 8; ++j) {
      const unsigned idx = (j & 1) ? (iw[j >> 1] >> 16) : (iw[j >> 1] & 0xFFFFu);
      if ((int)(idx >> 11) == x) {
        const int pos = atomicAdd(cnt, 1);
        pl[pos] = ((unsigned)(tid * 8 + j) << 16) | idx;
      }
    }
  }
  __syncthreads();
  const int n = *cnt;
  const unsigned char* ut = (const unsigned char*)(p.ws + OFF_UT) + (size_t)l * 16384 * 1024;
  float* abuf_tile = (float*)(p.ws + OFF_ABUF) + (size_t)tok0 * 128;
  const int me = ((lane >> 5) & 1) * 4 + ((lane >> 4) & 1) * 2 + ((lane >> 3) & 1);
  const int nch = (n + 7) >> 3;
  uint4 uA[8], uB[8];
  unsigned prA[8], prB[8];
  int ck = w;
  if (ck < nch) pu_load8(pl, ck * 8, n, ut, lane, uA, prA);
  while (ck < nch) {
    int nk = ck + 4;
    if (nk < nch) pu_load8(pl, nk * 8, n, ut, lane, uB, prB);
    pu_compute8(uA, prA, xs, gs, abuf_tile, lane, me);
    ck = nk;
    if (ck >= nch) break;
    nk = ck + 4;
    if (nk < nch) pu_load8(pl, nk * 8, n, ut, lane, uA, prA);
    pu_compute8(uB, prB, xs, gs, abuf_tile, lane, me);
    ck = nk;
  }
  __syncthreads();
}
__device__ __forceinline__ void phase_peer_u(const Params& p, int l, int xcc, u16* sm) {
  unsigned* qh = (unsigned*)(p.ws + OFF_QHEAD) + l * 8;
  volatile int* bc = (volatile int*)(sm + 24580);
  for (int pr = 0; pr < 8; ++pr) {
    const int x = (xcc + pr) & 7;
    for (;;) {
      if (otid() == 0) bc[0] = (int)atomicAdd(qh + x, 1u);
      __syncthreads();
      const int tile = bc[0];
      __syncthreads();
      if (tile >= TT / 16) break;
      peer_u_unit(p, l, x, tile, sm);
    }
  }
}

__device__ __forceinline__ void pv_load8(const u16* gi, const unsigned char* vtb, int lane, uint4 (&vv)[8]) {
  const uint4 iv = *(const uint4*)gi;
  const unsigned iw[4] = {iv.x, iv.y, iv.z, iv.w};
#pragma unroll
  for (int j = 0; j < 8; ++j) {
    const unsigned idx = (j & 1) ? (iw[j >> 1] >> 16) : (iw[j >> 1] & 0xFFFFu);
    vv[j] = *(const uint4*)(vtb + (size_t)idx * 1024 + lane * 16);
  }
}
__device__ __forceinline__ void pv_compute8(const uint4 (&vv)[8], const float* ap, f32x2 (&o2)[8]) {
  const float4 a0 = *(const float4*)ap, a1 = *(const float4*)(ap + 4);
  const float av[8] = {a0.x, a0.y, a0.z, a0.w, a1.x, a1.y, a1.z, a1.w};
#pragma unroll
  for (int j = 0; j < 8; ++j) {
    const unsigned vw[4] = {vv[j].x, vv[j].y, vv[j].z, vv[j].w};
    const f32x2 aj2 = {av[j], av[j]};
#pragma unroll
    for (int k = 0; k < 4; ++k) {
      f32x2 lo = __builtin_amdgcn_cvt_pk_f32_fp8((int)vw[k], false);
      f32x2 hi = __builtin_amdgcn_cvt_pk_f32_fp8((int)vw[k], true);
      o2[2 * k] = __builtin_elementwise_fma(aj2, lo, o2[2 * k]);
      o2[2 * k + 1] = __builtin_elementwise_fma(aj2, hi, o2[2 * k + 1]);
    }
  }
}
__device__ __forceinline__ void peer_v_item(const Params& p, int l, int it) {
  const int tid = otid(), lane = tid & 63, w = tid >> 6;
  const int t0 = it * 32;
  const unsigned char* vtb = (const unsigned char*)(p.ws + OFF_VT) + (size_t)l * 16384 * 1024;
  const u16* gidx = (const u16*)(p.ws + OFF_GIDX);
  const float* abuf = (const float*)(p.ws + OFF_ABUF);
  const float* mod = (const float*)(p.ws + OFF_MOD) + l * 3 * 6144;
  uint4 vA[8], vB[8];
  for (int tq = 0; tq < 8; ++tq) {
    const int tok = t0 + w * 8 + tq;
    const u16* gi = gidx + (size_t)tok * 128;
    const float* ap = abuf + (size_t)tok * 128;
    f32x2 o2[8];
#pragma unroll
    for (int i = 0; i < 8; ++i) o2[i] = (f32x2){0.f, 0.f};
    if (tq == 0) pv_load8(gi, vtb, lane, vA);
    for (int g8 = 0; g8 < 16; g8 += 2) {
      pv_load8(gi + (g8 + 1) * 8, vtb, lane, vB);
      pv_compute8(vA, ap + g8 * 8, o2);
      if (g8 + 2 < 16) pv_load8(gi + (g8 + 2) * 8, vtb, lane, vA);
      else if (tq < 7) pv_load8(gi + 128, vtb, lane, vA);
      pv_compute8(vB, ap + (g8 + 1) * 8, o2);
    }
    const float* gf = mod + mod_index(tok) * 6144 + 5 * 1024;
    float* orow = p.out + (size_t)tok * DM;
    float ssq = 0.f;
    float4 xf[4];
#pragma unroll
    for (int i = 0; i < 4; ++i) {
      int k = lane * 16 + i * 4;
      float4 xv = *(const float4*)(orow + k);
      float4 gv = *(const float4*)(gf + k);
      xv.x += gv.x * o2[i * 2][0]; xv.y += gv.y * o2[i * 2][1];
      xv.z += gv.z * o2[i * 2 + 1][0]; xv.w += gv.w * o2[i * 2 + 1][1];
      *(float4*)(orow + k) = xv;
      xf[i] = xv;
      ssq += xv.x * xv.x + xv.y * xv.y + xv.z * xv.z + xv.w * xv.w;
    }
    if (l == 0) {
      const float ss = wave_sum(ssq);
      const float rstd = rsqrtf(ss * (1.0f / 1024.0f) + 1e-6f);
      const float* g1 = p.norm_mix_g + DM;
      const float* mr = (const float*)(p.ws + OFF_MOD) + 3 * 6144 + mod_index(tok) * 6144;
      u16* hw_ = (u16*)(p.ws + OFF_HBUF) + (size_t)tok * DM;
#pragma unroll
      for (int i = 0; i < 4; ++i) {
        int k = lane * 16 + i * 4;
        float4 gg = *(const float4*)(g1 + k);
        float4 sh = *(const float4*)(mr + k);
        float4 sc = *(const float4*)(mr + 1024 + k);
        uint2 o;
        o.x = pk2(xf[i].x * rstd * gg.x * (1.0f + sc.x) + sh.x, xf[i].y * rstd * gg.y * (1.0f + sc.y) + sh.y);
        o.y = pk2(xf[i].z * rstd * gg.z * (1.0f + sc.z) + sh.z, xf[i].w * rstd * gg.w * (1.0f + sc.w) + sh.w);
        *(uint2*)(hw_ + k) = o;
      }
    }
  }
}
__device__ __forceinline__ void phase_peer_v(const Params& p, int l) {
  for (int it = obid(); it < TT / 32; it += gridDim.x) peer_v_item(p, l, it);
}
#endif

__device__ __forceinline__ void phase_peer(const Params& p, int l, u16* sm) {
  for (int it = obid(); it < TT / 32; it += gridDim.x) peer_item(p, l, it, sm);
}

#define XB_TMO      128
#define XB_XCNT(j)  (256  + 64 * (j))
#define XB_XSUB(j)  (1280 + 64 * (j))
#define XB_XGEN(j)  (2304 + 64 * (j))
#define XB_TOP      3328
#define XB_TOPGEN   3392
#define XCD_BAR_WORDS 3456
#define XB_SPIN_CAP (1u << 18)
#define LAS __attribute__((address_space(3)))

__device__ __forceinline__ unsigned xb_ld(unsigned* p)              { return __hip_atomic_load(p, __ATOMIC_RELAXED, __HIP_MEMORY_SCOPE_AGENT); }
__device__ __forceinline__ unsigned xb_add(unsigned* p, unsigned v) { return __hip_atomic_fetch_add(p, v, __ATOMIC_RELAXED, __HIP_MEMORY_SCOPE_AGENT); }
__device__ __forceinline__ unsigned xb_xcc_id() { return (unsigned)__builtin_amdgcn_s_getreg((3 << 11) | 20) & 0xFu; }
#define XB_SPIN(cond, bar) do { unsigned _sp = 0; while (cond) { __builtin_amdgcn_s_sleep(1); \
    if ((++_sp & 255u) == 0u) { if (xb_ld(&(bar)[XB_TMO])) break; if (_sp > XB_SPIN_CAP) { atomicAdd(&(bar)[XB_TMO], 1u); break; } } } } while (0)

struct XcdBarrier {
    unsigned* bar; unsigned x;
    volatile LAS unsigned* st;
};

__device__ __forceinline__ XcdBarrier xcd_barrier_post(unsigned* bar, volatile LAS unsigned* st) {
    XcdBarrier b; b.bar = bar; b.x = xb_xcc_id(); b.st = st;
    if (threadIdx.x == 0) (void)xb_add(&bar[XB_XCNT(b.x)], 1u);
    return b;
}
__device__ __forceinline__ void xcd_barrier_complete(unsigned* bar, unsigned x, unsigned& nloc, unsigned& nx) {
    const unsigned G = gridDim.x * gridDim.y * gridDim.z;
    unsigned sum, cnt, mine, sp = 0u;
    for (;;) {
        sum = 0u; cnt = 0u; mine = 0u;
#pragma unroll
        for (unsigned j = 0; j < 16; ++j) { const unsigned c = xb_ld(&bar[XB_XCNT(j)]); sum += c; cnt += (c > 0u) ? 1u : 0u; mine = (j == x) ? c : mine; }
        if (sum == G) break;
        __builtin_amdgcn_s_sleep(1);
        if ((++sp & 255u) == 0u) { if (xb_ld(&bar[XB_TMO])) break; if (sp > XB_SPIN_CAP) { atomicAdd(&bar[XB_TMO], 1u); break; } }
    }
    nloc = mine > 0u ? mine : 1u; nx = cnt > 0u ? cnt : 1u;
}

__device__ __forceinline__ void xcd_barrier(const XcdBarrier& b) {
    asm volatile("s_waitcnt vmcnt(0)" ::: "memory");
    __syncthreads();
    if (threadIdx.x == 0) {
        unsigned* bar = b.bar;
        __builtin_amdgcn_s_waitcnt(0);
        unsigned nloc = b.st[0], nx = b.st[1];
        if (nloc == 0u) { xcd_barrier_complete(bar, b.x, nloc, nx); b.st[0] = nloc; b.st[1] = nx; }
        const unsigned old = xb_add(&bar[XB_XSUB(b.x)], 1u);
        const unsigned gen = old / nloc;
        if (old + 1u == (gen + 1u) * nloc) {
            __builtin_amdgcn_fence(__ATOMIC_RELEASE, "agent");
            asm volatile("s_waitcnt vmcnt(0)" ::: "memory");
            const unsigned og = xb_add(&bar[XB_TOP], 1u);
            const unsigned tg = og / nx;
            if (og + 1u == (tg + 1u) * nx) xb_add(&bar[XB_TOPGEN], 1u);
            else XB_SPIN(xb_ld(&bar[XB_TOPGEN]) == tg, bar);
            __builtin_amdgcn_fence(__ATOMIC_ACQUIRE, "agent");
            xb_add(&bar[XB_XGEN(b.x)], 1u);
            asm volatile("s_waitcnt vmcnt(0)" ::: "memory");
        } else {
            XB_SPIN(xb_ld(&bar[XB_XGEN(b.x)]) == gen, bar);
            __builtin_amdgcn_fence(__ATOMIC_ACQUIRE, "agent");
            asm volatile("s_waitcnt vmcnt(0)" ::: "memory");
        }
    }
    __syncthreads();
}


constexpr int PPL = PEER_PART ? 10 : 8;
constexpr int NPHASE = 1 + 2 * PPL;
__device__ __forceinline__ void run_phase(const Params& p, int ph, int xcc, u16* sm) {
  if (ph == 0) { phase0(p, (float*)sm); return; }
  int l = (ph - 1) / PPL, s = (ph - 1) % PPL;
  switch (s) {
    case 0: phase_norm(p, l, 0); break;
    case 1: gemm_phase<0, 2048, 1024, 2048>(p, l, (const u16*)(p.ws + OFF_HBUF), (const u16*)(p.ws + OFF_WTIN) + (size_t)l * 2048 * 1024,
                          (u16*)(p.ws + OFF_PROJ), sm); break;
    case 2: phase_prep(p, l, sm); break;
    case 3: phase_mix(p, l, sm); break;
    case 4: gemm_phase<1, 1024, 1024, 1024>(p, l, (const u16*)(p.ws + OFF_MIX), (const u16*)(p.ws + OFF_WTOUT) + (size_t)l * 1024 * 1024,
                          nullptr, sm); break;
    case 5: phase_norm(p, l, 1); break;
    case 6: gemm_phase<0, 1024, 1024, 1024>(p, l, (const u16*)(p.ws + OFF_HBUF), (const u16*)(p.ws + OFF_WTQ) + (size_t)l * 1024 * 1024,
                          (u16*)(p.ws + OFF_QP), sm); break;
    case 7: phase_peer(p, l, sm); break;
#if PEER_PART
    case 8: phase_peer_u(p, l, xcc, sm); break;
    case 9: phase_peer_v(p, l); break;
#endif
  }
}

__global__ void __launch_bounds__(256, 2) mega(Params p, int ph_lo, int ph_hi) {
  __shared__ __attribute__((aligned(16))) u16 sm[32768];
  cg::grid_group grid = cg::this_grid();
  uint4* xbw = (uint4*)(sm + 32760);
  if (threadIdx.x == 0) *xbw = make_uint4(0u, 0u, 0u, 0u);
  __syncthreads();
  XcdBarrier xb = xcd_barrier_post((unsigned*)(p.ws + OFF_BAR), (volatile LAS unsigned*)xbw);
  if (ph_hi == 0x7fffffff) grid.sync();
  for (int ph = ph_lo; ph <= ph_hi; ++ph) {
    if (ph == 1 + PPL) continue;
    run_phase(p, ph, (int)(xb.x & 7u), sm);
#ifdef REP_PHASE
    if (ph == REP_PHASE) { xcd_barrier(xb); run_phase(p, ph, (int)(xb.x & 7u), sm); }
#endif
    if (ph < ph_hi) xcd_barrier(xb);
  }
}

extern "C" void kernel_launch(void* const* d_in, const int* in_sizes, int n_in, void* d_out, int out_size, void* d_ws, size_t ws_size,
                              hipStream_t stream) {
  static int grid_blocks = 0;
  if (!grid_blocks) {
    int dev = 0, cus = 0, per_cu = 0;
    hipGetDevice(&dev);
    hipDeviceGetAttribute(&cus, hipDeviceAttributeMultiprocessorCount, dev);
    hipOccupancyMaxActiveBlocksPerMultiprocessor(&per_cu, mega, 256, 0);
    if (per_cu > 2) per_cu = 2;
    if (per_cu < 1) per_cu = 1;
    grid_blocks = cus * per_cu;
  }
  if (ws_size < WS_NEED) { fprintf(stderr, "workspace too small: %zu < %zu\n", ws_size, (size_t)WS_NEED); return; }
  Params p{};
  const float** pf = (const float**)&p;
  for (int i = 0; i < 32; ++i) pf[i] = (const float*)d_in[i];
  p.out = (float*)d_out;
  p.ws = (char*)d_ws;
  hipMemsetAsync((char*)d_ws + OFF_BAR, 0, 16384, stream);
#if ONE_LAUNCH
  int lo = 0, hi = NPHASE - 1;
  void* args[] = {&p, &lo, &hi};
  hipError_t e = hipLaunchCooperativeKernel((void*)mega, dim3(grid_blocks), dim3(256), args, 0, stream);
  if (e != hipSuccess) fprintf(stderr, "cooperative launch failed: %s (grid %d)\n", hipGetErrorString(e), grid_blocks);
#else
  for (int ph = 0; ph < NPHASE; ++ph) {
    int lo = ph, hi = ph;
    void* args[] = {&p, &lo, &hi};
    hipError_t e = hipLaunchCooperativeKernel((void*)mega, dim3(grid_blocks), dim3(256), args, 0, stream);
    if (e != hipSuccess) fprintf(stderr, "cooperative launch failed: %s (grid %d)\n", hipGetErrorString(e), grid_blocks);
  }
#endif
}
```

```cpp
#include <hip/hip_runtime.h>
#include <hip/hip_cooperative_groups.h>
#include <cstdio>
#include <cstdint>
namespace cg = cooperative_groups;

#ifndef PEER_PART
#define PEER_PART 0
#endif
#ifndef ONE_LAUNCH
#define ONE_LAUNCH 1
#endif

typedef unsigned short u16;
typedef __attribute__((ext_vector_type(8))) short bf16x8;
typedef __attribute__((ext_vector_type(16))) float f32x16;
typedef __attribute__((ext_vector_type(4))) float f32x4;
typedef __attribute__((ext_vector_type(2))) float f32x2;

constexpr int DM = 1024;
constexpr int TP = 8192;
constexpr int TT = 16384;
constexpr int LS = 4096;
constexpr int LP = 256;
constexpr int NKS = 4352;
constexpr int INW = 2048;
constexpr int HFS_STRIDE = 8208;
constexpr int HFS_OFF = 4112;
constexpr int HFP_STRIDE = 528;
constexpr int HFP_OFF = 272;

constexpr size_t al(size_t x) { return (x + 255) & ~(size_t)255; }
constexpr size_t OFF_MOD  = 0;
constexpr size_t OFF_ROPE = al(OFF_MOD + (size_t)2 * 3 * 6144 * 4);
constexpr size_t OFF_WTIN = al(OFF_ROPE + (size_t)4096 * 32 * 8);
constexpr size_t OFF_WTOUT = al(OFF_WTIN + (size_t)2 * 2048 * 1024 * 2);
constexpr size_t OFF_WTQ  = al(OFF_WTOUT + (size_t)2 * 1024 * 1024 * 2);
constexpr size_t OFF_KEYS = al(OFF_WTQ + (size_t)2 * 1024 * 1024 * 2);
constexpr size_t OFF_WSB  = al(OFF_KEYS + (size_t)2 * 8 * 2 * 128 * 64 * 2);
constexpr size_t OFF_HFS  = al(OFF_WSB + (size_t)2 * 4 * 128 * 128 * 2);
constexpr size_t OFF_HFP  = al(OFF_HFS + (size_t)2 * 256 * HFS_STRIDE * 4);
constexpr size_t OFF_HBUF = al(OFF_HFP + (size_t)2 * 256 * HFP_STRIDE * 4);
constexpr size_t OFF_PROJ = al(OFF_HBUF + (size_t)TT * 1024 * 2);
constexpr size_t OFF_QN   = al(OFF_PROJ + (size_t)TT * 2048 * 2);
constexpr size_t OFF_KP   = al(OFF_QN + (size_t)TT * 512 * 2);
constexpr size_t OFF_VTP  = al(OFF_KP + (size_t)32 * 2 * 256 * 64 * 2);
constexpr size_t OFF_KS   = al(OFF_VTP + (size_t)32 * 2 * 64 * 256 * 2);
constexpr size_t OFF_VTS  = al(OFF_KS + (size_t)2 * 2 * NKS * 64 * 2);
constexpr size_t OFF_UB   = al(OFF_VTS + (size_t)2 * 2 * 64 * NKS * 2);
constexpr size_t OFF_X0   = al(OFF_UB + (size_t)TT * 256 * 2);
constexpr size_t OFF_UG   = al(OFF_X0 + (size_t)TT * 256 * 2);
constexpr size_t OFF_VGN  = al(OFF_UG + (size_t)TT * 256 * 2);
constexpr size_t OFF_MIX  = al(OFF_VGN + (size_t)TT * 256 * 2);
constexpr size_t OFF_QP   = al(OFF_MIX + (size_t)TT * 1024 * 2);
constexpr size_t OFF_UT   = al(OFF_QP + (size_t)TT * 1024 * 2);
constexpr size_t OFF_VT   = al(OFF_UT + (size_t)2 * 16384 * 1024);
constexpr size_t OFF_UTB  = al(OFF_VT + (size_t)2 * 16384 * 1024);
constexpr size_t OFF_KMAX = al(OFF_UTB + (size_t)2 * 256 * 4096 * 2);
constexpr size_t OFF_GIDX = al(OFF_KMAX + 1024);
constexpr size_t OFF_GGATE = al(OFF_GIDX + (size_t)TT * 128 * 2);
constexpr size_t OFF_ABUF = al(OFF_GGATE + (size_t)TT * 128 * 4);
constexpr size_t OFF_BAR  = al(OFF_ABUF + (size_t)TT * 128 * 4);
constexpr size_t OFF_QHEAD = OFF_BAR + 14336;
constexpr size_t WS_NEED  = al(OFF_BAR + 16384);

struct Params {
  const float *x_prompt, *x_sample, *cache_k, *cache_v, *c, *c_ctx, *norm_mix_g, *norm_ffn_g, *ada_w, *ada_b,
      *w_in, *w_out, *q_norm_g, *k_norm_g, *hy_conv_w, *hy_conv_b, *hy_fw1, *hy_fb1, *hy_freq1, *hy_fw2, *hy_fb2,
      *hy_freq2, *hy_fw3, *hy_decay, *hy_skip, *sg_norm_g, *sg_w, *sg_b, *peer_wq, *peer_keys, *peer_u, *peer_v;
  float* out;
  char* ws;
};

__device__ __forceinline__ u16 f2bf(float f) {
  unsigned u = __float_as_uint(f);
  u += 0x7FFFu + ((u >> 16) & 1u);
  return (u16)(u >> 16);
}
__device__ __forceinline__ float bf2f(u16 h) { return __uint_as_float(((unsigned)h) << 16); }
typedef __attribute__((ext_vector_type(2))) __bf16 bf16x2v;
__device__ __forceinline__ unsigned pk2(float lo, float hi) {
  __attribute__((ext_vector_type(2))) float v = {lo, hi};
  bf16x2v b = __builtin_convertvector(v, bf16x2v);
  return __builtin_bit_cast(unsigned, b);
}
__device__ __forceinline__ float gelu_t(float x) {
  float u = 0.7978845608028654f * (x + 0.044715f * x * x * x);
  float e = __expf(2.0f * u);
  float t = 1.0f - 2.0f / (e + 1.0f);
  return 0.5f * x * (1.0f + t);
}
__device__ __forceinline__ float wave_sum(float v) {
  v += __shfl_xor(v, 32); v += __shfl_xor(v, 16); v += __shfl_xor(v, 8);
  v += __shfl_xor(v, 4);  v += __shfl_xor(v, 2);  v += __shfl_xor(v, 1);
  return v;
}
__device__ __forceinline__ int mod_index(int tok) { return tok < TP ? 0 : 1 + ((tok - TP) >> 12); }
__device__ __forceinline__ const float* x_in_row(const Params& p, int l, int tok) {
  if (l == 0) return tok < TP ? p.x_prompt + (size_t)tok * DM : p.x_sample + (size_t)(tok - TP) * DM;
  return p.out + (size_t)tok * DM;
}
__device__ __forceinline__ int otid() { int t = __builtin_amdgcn_workitem_id_x(); asm volatile("" : "+v"(t)); return t; }
__device__ __forceinline__ int obid() { int t = __builtin_amdgcn_workgroup_id_x(); asm volatile("" : "+s"(t)); return t; }
#define MFMA32(a, b, c) __builtin_amdgcn_mfma_f32_32x32x16_bf16(a, b, c, 0, 0, 0)

__device__ __forceinline__ void ph0_mod(const Params& p, int it, float* sm) {
  const int tid = otid();
  int l = it / 48, ch = it % 48;
  const int col0 = ch * 128;
  float* sv = sm;
  for (int i = tid; i < 3072; i += 256) {
    int v = i >> 10, k = i & 1023;
    float cv = (v == 0) ? p.c_ctx[k] : p.c[(v - 1) * 1024 + k];
    sv[i] = cv / (1.0f + expf(-cv));
  }
  __syncthreads();
  const int cg4 = tid & 31, kg = tid >> 5;
  const float* w = p.ada_w + ((size_t)l * 1024 + kg * 128) * 6144 + col0 + cg4 * 4;
  float4 acc[3];
#pragma unroll
  for (int v = 0; v < 3; ++v) acc[v] = make_float4(0.f, 0.f, 0.f, 0.f);
  for (int k8 = 0; k8 < 128; k8 += 8) {
    float4 wr[8];
#pragma unroll
    for (int k = 0; k < 8; ++k) wr[k] = *(const float4*)(w + (size_t)(k8 + k) * 6144);
#pragma unroll
    for (int k = 0; k < 8; ++k)
#pragma unroll
      for (int v = 0; v < 3; ++v) {
        float sc = sv[v * 1024 + kg * 128 + k8 + k];
        acc[v].x += sc * wr[k].x; acc[v].y += sc * wr[k].y; acc[v].z += sc * wr[k].z; acc[v].w += sc * wr[k].w;
      }
  }
  float4* red = (float4*)(sm + 3072);
#pragma unroll
  for (int v = 0; v < 3; ++v) red[(kg * 3 + v) * 32 + cg4] = acc[v];
  __syncthreads();
  if (tid < 96) {
    int v = tid >> 5, cc = tid & 31;
    float4 s4 = *(const float4*)(p.ada_b + l * 6144 + col0 + cc * 4);
    for (int g = 0; g < 8; ++g) {
      float4 r = red[(g * 3 + v) * 32 + cc];
      s4.x += r.x; s4.y += r.y; s4.z += r.z; s4.w += r.w;
    }
    float* mod = (float*)(p.ws + OFF_MOD);
    *(float4*)(mod + (l * 3 + v) * 6144 + col0 + cc * 4) = s4;
  }
  __syncthreads();
}

__device__ __forceinline__ void ph0_transpose(const float* src, u16* dst, int K, int N, int k0, int n0, float* sm) {
  const int tid = otid();
#pragma unroll
  for (int i = 0; i < 16; ++i) {
    int idx = tid + 256 * i, r = idx >> 6, cc = idx & 63;
    sm[r * 65 + cc] = src[(size_t)(k0 + r) * N + n0 + cc];
  }
  __syncthreads();
#pragma unroll
  for (int i = 0; i < 16; ++i) {
    int idx = tid + 256 * i, r = idx >> 6, cc = idx & 63;
    dst[(size_t)(n0 + r) * K + k0 + cc] = f2bf(sm[cc * 65 + r]);
  }
  __syncthreads();
}

__device__ __forceinline__ void ph0_filter(const Params& p, int l, int L, int t0, float* dst, int stride, int off, float* sm) {
  const int tid = otid();
  float* feats = sm;
  float* h1 = sm + 16 * 33;
  float* h2 = h1 + 16 * 64;
  for (int idx = tid; idx < 16 * 33; idx += 256) {
    int tt = idx / 33, j = idx % 33;
    float t = (float)(t0 + tt);
    float val;
    if (j == 0) val = t / (float)(L - 1);
    else {
      int b = (j - 1) & 15;
      float f = 1e-4f + (float)b * ((15.0f - 1e-4f) / 15.0f);
      float w = 2.0f * 3.14159265358979323846f * t / (float)L;
      float z = w * f;
      val = (j <= 16) ? cosf(z) : -sinf(z);
    }
    feats[idx] = val;
  }
  __syncthreads();
  {
    int j = tid & 63, tq = tid >> 6;
    const float* fw1 = p.hy_fw1 + l * 33 * 64;
    float fb = p.hy_fb1[l * 64 + j], fr = p.hy_freq1[l * 64 + j];
    for (int q = 0; q < 4; ++q) {
      int tt = tq * 4 + q;
      float s = fb;
      for (int i = 0; i < 33; ++i) s += feats[tt * 33 + i] * fw1[i * 64 + j];
      h1[tt * 64 + j] = sinf(fr * s);
    }
  }
  __syncthreads();
  {
    int j = tid & 63, tq = tid >> 6;
    const float* fw2 = p.hy_fw2 + l * 64 * 64;
    float fb = p.hy_fb2[l * 64 + j], fr = p.hy_freq2[l * 64 + j];
    for (int q = 0; q < 4; ++q) {
      int tt = tq * 4 + q;
      float s = fb;
      for (int i = 0; i < 64; ++i) s += h1[tt * 64 + i] * fw2[i * 64 + j];
      h2[tt * 64 + j] = sinf(fr * s);
    }
  }
  __syncthreads();
  {
    const float* fw3 = p.hy_fw3 + (size_t)l * 64 * 512;
    float acc0[16], acc1[16];
#pragma unroll
    for (int t = 0; t < 16; ++t) { acc0[t] = 0.f; acc1[t] = 0.f; }
    for (int j = 0; j < 64; ++j) {
      float wa = fw3[j * 512 + tid], wb = fw3[j * 512 + 256 + tid];
#pragma unroll
      for (int t = 0; t < 16; ++t) {
        float hv = h2[t * 64 + j];
        acc0[t] += hv * wa; acc1[t] += hv * wb;
      }
    }
    float d0 = fabsf(p.hy_decay[l * 512 + tid]), d1 = fabsf(p.hy_decay[l * 512 + 256 + tid]);
#pragma unroll
    for (int t = 0; t < 16; ++t) {
      int tg = t0 + t;
      float tn = (float)tg / (float)(L - 1);
      acc0[t] *= expf(-tn * d0);
      acc1[t] *= expf(-tn * d1);
    }
    u16* rc = (u16*)dst + (size_t)tid * stride;
    const int roff = off;
#pragma unroll
    for (int t = 0; t < 16; ++t) {
      const int tg = t0 + t;
      rc[roff - tg] = f2bf(acc0[t]);
      if (tg >= 1) rc[roff + tg] = f2bf(acc1[t]);
    }
    if (t0 == 0) {
      for (int i = 0; i <= roff - L; ++i) rc[i] = (u16)0;
    }
  }
  __syncthreads();
}

constexpr int P0_MOD = 96;
constexpr int P0_TIN = 1024, P0_TOUT = 512, P0_TQ = 512;
constexpr int P0_KEYS = 256, P0_SGW = 128, P0_ROPE = 512;
constexpr int P0_FS = 512, P0_FP = 32;
constexpr int P0_TAB = 4096;
constexpr int P0_TOTAL = P0_MOD + P0_TIN + P0_TOUT + P0_TQ + P0_KEYS + P0_SGW + P0_ROPE + P0_FS + P0_FP;

__device__ __forceinline__ void phase0(const Params& p, float* sm) {
  const int tid = otid();
  if (obid() == 0 && tid < 136) ((unsigned*)(p.ws + OFF_KMAX))[tid] = 0u;
  for (int it0 = obid(); it0 < P0_TOTAL; it0 += gridDim.x) {
    int it = it0;
    if (it < P0_MOD) { ph0_mod(p, it, sm); continue; }
    it -= P0_MOD;
    if (it < P0_TIN) {
      int l = it >> 9, r = it & 511, kt = r >> 5, nt = r & 31;
      ph0_transpose(p.w_in + (size_t)l * 1024 * 2048, (u16*)(p.ws + OFF_WTIN) + (size_t)l * 2048 * 1024, 1024, 2048, kt * 64, nt * 64, sm);
      continue;
    }
    it -= P0_TIN;
    if (it < P0_TOUT) {
      int l = it >> 8, r = it & 255, kt = r >> 4, nt = r & 15;
      ph0_transpose(p.w_out + (size_t)l * 1024 * 1024, (u16*)(p.ws + OFF_WTOUT) + (size_t)l * 1024 * 1024, 1024, 1024, kt * 64, nt * 64, sm);
      continue;
    }
    it -= P0_TOUT;
    if (it < P0_TQ) {
      int l = it >> 8, r = it & 255, kt = r >> 4, nt = r & 15;
      ph0_transpose(p.peer_wq + (size_t)l * 1024 * 1024, (u16*)(p.ws + OFF_WTQ) + (size_t)l * 1024 * 1024, 1024, 1024, kt * 64, nt * 64, sm);
      continue;
    }
    it -= P0_TQ;
    if (it < P0_KEYS) {
      u16* d = (u16*)(p.ws + OFF_KEYS);
      for (int i = 0; i < 4; ++i) { int e = it * 1024 + i * 256 + tid; d[e] = f2bf(p.peer_keys[e]); }
      continue;
    }
    it -= P0_KEYS;
    if (it < P0_SGW) {
      u16* d = (u16*)(p.ws + OFF_WSB);
      for (int i = 0; i < 4; ++i) { int e = it * 1024 + i * 256 + tid; d[e] = f2bf(p.sg_w[e]); }
      continue;
    }
    it -= P0_SGW;
    if (it < P0_ROPE) {
      int e = it * 256 + tid;
      int pos = e >> 5, i = e & 31;
      int row = pos >> 6, col = pos & 63;
      float inv = powf(10000.0f, -(float)(i & 15) / 16.0f);
      float ang = (float)(i < 16 ? row : col) * inv;
      float s, cs;
      sincosf(ang, &s, &cs);
      float2* rt = (float2*)(p.ws + OFF_ROPE);
      rt[e] = make_float2(cs, s);
      continue;
    }
    it -= P0_ROPE;
    if (it < P0_FS) {
      int l = it >> 8, t0 = (it & 255) * 16;
      ph0_filter(p, l, LS, t0, (float*)((u16*)(p.ws + OFF_HFS) + (size_t)l * 256 * HFS_STRIDE), HFS_STRIDE, HFS_OFF, sm);
      continue;
    }
    it -= P0_FS;
    if (it < P0_FP) {
      int l = it >> 4, t0 = (it & 15) * 16;
      ph0_filter(p, l, LP, t0, (float*)((u16*)(p.ws + OFF_HFP) + (size_t)l * 256 * HFP_STRIDE), HFP_STRIDE, HFP_OFF, sm);
      continue;
    }
    it -= P0_FP;
    {
      (void)it;
    }
  }
}

__device__ __forceinline__ void phase_norm(const Params& p, int l, int which) {
  const int lane = otid() & 63, w = otid() >> 6;
  const float* g = (which == 0 ? p.norm_mix_g : p.norm_ffn_g) + l * DM;
  const float* mod = (const float*)(p.ws + OFF_MOD) + l * 3 * 6144;
  u16* hb = (u16*)(p.ws + OFF_HBUF);
  for (int it = obid(); it < TT / 4; it += gridDim.x) {
    int tok = it * 4 + w;
    const float* xr = which ? p.out + (size_t)tok * DM : x_in_row(p, l, tok);
    const float* mr = mod + mod_index(tok) * 6144 + (which ? 3 * 1024 : 0);
    float4 v[4];
    float ss = 0.f;
#pragma unroll
    for (int i = 0; i < 4; ++i) {
      v[i] = *(const float4*)(xr + lane * 4 + 256 * i);
      ss += v[i].x * v[i].x + v[i].y * v[i].y + v[i].z * v[i].z + v[i].w * v[i].w;
    }
    ss = wave_sum(ss);
    float rstd = rsqrtf(ss * (1.0f / 1024.0f) + 1e-6f);
#pragma unroll
    for (int i = 0; i < 4; ++i) {
      int k = lane * 4 + 256 * i;
      float4 gg = *(const float4*)(g + k);
      float4 sh = *(const float4*)(mr + k);
      float4 sc = *(const float4*)(mr + 1024 + k);
      float o0 = v[i].x * rstd * gg.x * (1.0f + sc.x) + sh.x;
      float o1 = v[i].y * rstd * gg.y * (1.0f + sc.y) + sh.y;
      float o2 = v[i].z * rstd * gg.z * (1.0f + sc.z) + sh.z;
      float o3 = v[i].w * rstd * gg.w * (1.0f + sc.w) + sh.w;
      uint2 o; o.x = pk2(o0, o1); o.y = pk2(o2, o3);
      *(uint2*)(hb + (size_t)tok * DM + k) = o;
    }
  }
}

template <int EPI, int N, int K, int LDC>
__device__ __forceinline__ void gemm_phase(const Params& p, int l, const u16* A, const u16* Bt, u16* C16, u16* sm) {
  const int tid = otid(), lane = tid & 63, w = tid >> 6;
  const int wm = w >> 1, wn = w & 1, hw = lane >> 5, r = lane & 31;
  u16* As = sm;
  u16* Bs = sm + 256 * 72;
  constexpr int ntn = N / 128;
  constexpr int ntiles = (TT / 256) * ntn;
  constexpr int nk = K / 64;
  for (int tile0 = obid(); tile0 < ntiles; tile0 += gridDim.x) {
    int tile = tile0;
    if ((gridDim.x & 511) == 0) {
      const int pass = tile0 / 512, b = tile0 & 511;
      const int xcd = b & 7, j = b >> 3;
      constexpr int mt_per_xcd = 64 / ntn;
      const int mt = pass * (512 / ntn) + xcd * mt_per_xcd + j / ntn;
      tile = mt * ntn + (j % ntn);
    }
    const int m0 = (tile / ntn) * 256, n0 = (tile % ntn) * 128;
    f32x16 acc[4][2];
#pragma unroll
    for (int a = 0; a < 4; ++a)
#pragma unroll
      for (int b = 0; b < 2; ++b)
#pragma unroll
        for (int e = 0; e < 16; ++e) acc[a][b][e] = 0.f;
    const int lrow = tid >> 3, lcc = tid & 7;
    const u16* Ag = A + (size_t)(m0 + lrow) * K + lcc * 8;
    const u16* Bg = Bt + (size_t)(n0 + lrow) * K + lcc * 8;
    uint4 ra0 = *(const uint4*)(Ag), ra1 = *(const uint4*)(Ag + 32 * K), ra2 = *(const uint4*)(Ag + 64 * K), ra3 = *(const uint4*)(Ag + 96 * K);
    uint4 ra4 = *(const uint4*)(Ag + 128 * K), ra5 = *(const uint4*)(Ag + 160 * K), ra6 = *(const uint4*)(Ag + 192 * K), ra7 = *(const uint4*)(Ag + 224 * K);
    uint4 rb0 = *(const uint4*)(Bg), rb1 = *(const uint4*)(Bg + 32 * K), rb2 = *(const uint4*)(Bg + 64 * K), rb3 = *(const uint4*)(Bg + 96 * K);
    u16* Aw = As + lrow * 72 + lcc * 8;
    u16* Bw = Bs + lrow * 72 + lcc * 8;
    const u16* Ar = As + (wm * 128 + r) * 72 + hw * 8;
    const u16* Br = Bs + (wn * 64 + r) * 72 + hw * 8;
    for (int kt = 0; kt < nk; ++kt) {
      __syncthreads();
      *(uint4*)(Aw) = ra0; *(uint4*)(Aw + 32 * 72) = ra1; *(uint4*)(Aw + 64 * 72) = ra2; *(uint4*)(Aw + 96 * 72) = ra3;
      *(uint4*)(Aw + 128 * 72) = ra4; *(uint4*)(Aw + 160 * 72) = ra5; *(uint4*)(Aw + 192 * 72) = ra6; *(uint4*)(Aw + 224 * 72) = ra7;
      *(uint4*)(Bw) = rb0; *(uint4*)(Bw + 32 * 72) = rb1; *(uint4*)(Bw + 64 * 72) = rb2; *(uint4*)(Bw + 96 * 72) = rb3;
      __syncthreads();
      if (kt + 1 < nk) {
        const u16* Ag2 = Ag + (kt + 1) * 64;
        const u16* Bg2 = Bg + (kt + 1) * 64;
        ra0 = *(const uint4*)(Ag2); ra1 = *(const uint4*)(Ag2 + 32 * K); ra2 = *(const uint4*)(Ag2 + 64 * K); ra3 = *(const uint4*)(Ag2 + 96 * K);
        ra4 = *(const uint4*)(Ag2 + 128 * K); ra5 = *(const uint4*)(Ag2 + 160 * K); ra6 = *(const uint4*)(Ag2 + 192 * K); ra7 = *(const uint4*)(Ag2 + 224 * K);
        rb0 = *(const uint4*)(Bg2); rb1 = *(const uint4*)(Bg2 + 32 * K); rb2 = *(const uint4*)(Bg2 + 64 * K); rb3 = *(const uint4*)(Bg2 + 96 * K);
      }
#pragma unroll
      for (int ks = 0; ks < 4; ++ks) {
        bf16x8 wf0 = *(const bf16x8*)(Br + ks * 16);
        bf16x8 wf1 = *(const bf16x8*)(Br + 32 * 72 + ks * 16);
#pragma unroll
        for (int mi = 0; mi < 4; ++mi) {
          bf16x8 xf = *(const bf16x8*)(Ar + mi * 32 * 72 + ks * 16);
          acc[mi][0] = MFMA32(wf0, xf, acc[mi][0]);
          acc[mi][1] = MFMA32(wf1, xf, acc[mi][1]);
        }
      }
    }
    const int mrow = m0 + wm * 128 + r;
    const int ncol = n0 + wn * 64 + 4 * hw;
    if (EPI == 0) {
      __syncthreads();
      u16* Cs = sm + w * (64 * 72);
#pragma unroll
      for (int rnd = 0; rnd < 2; ++rnd) {
#pragma unroll
        for (int ml = 0; ml < 2; ++ml) {
          const int mi = rnd * 2 + ml;
#pragma unroll
          for (int ni = 0; ni < 2; ++ni)
#pragma unroll
            for (int g = 0; g < 4; ++g) {
              uint2 o;
              o.x = pk2(acc[mi][ni][g * 4 + 0], acc[mi][ni][g * 4 + 1]);
              o.y = pk2(acc[mi][ni][g * 4 + 2], acc[mi][ni][g * 4 + 3]);
              *(uint2*)(Cs + (ml * 32 + r) * 72 + ni * 32 + g * 8 + 4 * hw) = o;
            }
        }
        u16* cg = C16 + (size_t)(m0 + wm * 128 + rnd * 64) * LDC + n0 + wn * 64;
#pragma unroll
        for (int i = 0; i < 8; ++i) {
          const int id = lane + 64 * i, row = id >> 3, cc = id & 7;
          *(uint4*)(cg + (size_t)row * LDC + cc * 8) = *(const uint4*)(Cs + row * 72 + cc * 8);
        }
      }
    } else {
      __syncthreads();
      float* Cf = (float*)sm + w * (32 * 68);
      const int cc = lane & 15;
      const float4 gm = *(const float4*)((const float*)(p.ws + OFF_MOD) + l * 3 * 6144 + mod_index(m0) * 6144 + 2 * 1024 + n0 + wn * 64 + cc * 4);
#pragma unroll
      for (int mi = 0; mi < 4; ++mi) {
#pragma unroll
        for (int ni = 0; ni < 2; ++ni)
#pragma unroll
          for (int g = 0; g < 4; ++g)
            *(float4*)(Cf + r * 68 + ni * 32 + g * 8 + 4 * hw) =
                make_float4(acc[mi][ni][g * 4 + 0], acc[mi][ni][g * 4 + 1], acc[mi][ni][g * 4 + 2], acc[mi][ni][g * 4 + 3]);
#pragma unroll
        for (int i = 0; i < 8; ++i) {
          const int row = (lane >> 4) + 4 * i;
          const int grow = m0 + wm * 128 + mi * 32 + row;
          const int gcol = n0 + wn * 64 + cc * 4;
          const float4 av = *(const float4*)(Cf + row * 68 + cc * 4);
          float4 xv = *(const float4*)(x_in_row(p, l, grow) + gcol);
          xv.x += gm.x * av.x; xv.y += gm.y * av.y; xv.z += gm.z * av.z; xv.w += gm.w * av.w;
          *(float4*)(p.out + (size_t)grow * DM + gcol) = xv;
        }
      }
    }
  }
}

__device__ __forceinline__ void prep_qkv_item(const Params& p, int l, int it, u16* sm) {
  const int tid = otid();
  const int t0 = it * 64;
  const bool samp = t0 >= TP;
  const u16* proj = (const u16*)(p.ws + OFF_PROJ);
  u16* qn = (u16*)(p.ws + OFF_QN);
  int seq, pos0;
  if (!samp) { seq = t0 >> 8; pos0 = t0 & 255; } else { seq = (t0 - TP) >> 12; pos0 = (t0 - TP) & 4095; }
  const float2* rope = (const float2*)(p.ws + OFF_ROPE);
  float* ck_out = p.out + (size_t)TT * DM;
  float* cv_out = ck_out + (size_t)32 * 2 * 256 * 128;
  unsigned* lk = (unsigned*)(sm + 16384);
  if (tid < 2) lk[tid] = 0u;
  __syncthreads();
  for (int unit = tid; unit < 640; unit += 256) {
    int tl = unit / 10, hh = unit % 10;
    int tok = t0 + tl, pos = pos0 + tl;
    const u16* src = proj + (size_t)tok * INW + hh * 64;
    float x[64];
    float ss = 0.f;
#pragma unroll
    for (int c8 = 0; c8 < 8; ++c8) {
      uint4 v = *(const uint4*)(src + c8 * 8);
      unsigned wv[4] = {v.x, v.y, v.z, v.w};
#pragma unroll
      for (int j = 0; j < 4; ++j) {
        float lo = __uint_as_float(wv[j] << 16), hi = __uint_as_float(wv[j] & 0xFFFF0000u);
        x[c8 * 8 + 2 * j] = lo; x[c8 * 8 + 2 * j + 1] = hi;
        ss += lo * lo + hi * hi;
      }
    }
    float rstd = rsqrtf(ss * (1.0f / 64.0f) + 1e-6f);
    const float* g = (hh < 8 ? p.q_norm_g : p.k_norm_g) + l * 64;
#pragma unroll
    for (int i = 0; i < 64; ++i) x[i] = x[i] * rstd * g[i];
    if (hh >= 8) {
      float k2 = 0.f;
#pragma unroll
      for (int i = 0; i < 64; ++i) k2 += x[i] * x[i];
      atomicMax(lk + (hh - 8), __float_as_uint(k2));
    }
    if (hh >= 8 && !samp) {
      float* d = ck_out + (((size_t)seq * 2 + l) * 256 + pos) * 128 + (hh - 8) * 64;
#pragma unroll
      for (int i = 0; i < 16; ++i) *(float4*)(d + 4 * i) = make_float4(x[4 * i], x[4 * i + 1], x[4 * i + 2], x[4 * i + 3]);
    }
    if (samp) {
#pragma unroll
      for (int i = 0; i < 32; ++i) {
        float2 cs = rope[pos * 32 + i];
        float a = x[2 * i], b = x[2 * i + 1];
        x[2 * i] = a * cs.x - b * cs.y;
        x[2 * i + 1] = a * cs.y + b * cs.x;
      }
    }
    u16* dst;
    float scl = 1.0f;
    if (hh < 8) { dst = qn + (size_t)tok * 512 + hh * 64; scl = 0.125f * 1.4426950408889634f; }
    else if (!samp) dst = (u16*)(p.ws + OFF_KP) + (((size_t)seq * 2 + (hh - 8)) * 256 + pos) * 64;
    else dst = (u16*)(p.ws + OFF_KS) + (((size_t)seq * 2 + (hh - 8)) * NKS + 256 + pos) * 64;
#pragma unroll
    for (int c8 = 0; c8 < 8; ++c8) {
      uint4 o;
      o.x = pk2(x[c8 * 8 + 0] * scl, x[c8 * 8 + 1] * scl);
      o.y = pk2(x[c8 * 8 + 2] * scl, x[c8 * 8 + 3] * scl);
      o.z = pk2(x[c8 * 8 + 4] * scl, x[c8 * 8 + 5] * scl);
      o.w = pk2(x[c8 * 8 + 6] * scl, x[c8 * 8 + 7] * scl);
      *(uint4*)(dst + c8 * 8) = o;
    }
  }
  u16* vt = sm;
#pragma unroll
  for (int i = 0; i < 4; ++i) {
    const int id = tid + 256 * i, tl = id >> 4, c8 = (id & 15) * 8;
    const uint4 hv = *(const uint4*)(proj + (size_t)(t0 + tl) * INW + 640 + c8);
    const unsigned wv[4] = {hv.x, hv.y, hv.z, hv.w};
#pragma unroll
    for (int j = 0; j < 4; ++j) {
      vt[(c8 + 2 * j) * 72 + tl] = (u16)(wv[j] & 0xFFFFu);
      vt[(c8 + 2 * j + 1) * 72 + tl] = (u16)(wv[j] >> 16);
    }
    if (!samp) {
      float* d = cv_out + (((size_t)seq * 2 + l) * 256 + pos0 + tl) * 128 + c8;
      *(float4*)(d) = make_float4(__uint_as_float(wv[0] << 16), __uint_as_float(wv[0] & 0xFFFF0000u), __uint_as_float(wv[1] << 16), __uint_as_float(wv[1] & 0xFFFF0000u));
      *(float4*)(d + 4) = make_float4(__uint_as_float(wv[2] << 16), __uint_as_float(wv[2] & 0xFFFF0000u), __uint_as_float(wv[3] << 16), __uint_as_float(wv[3] & 0xFFFF0000u));
    }
  }
  __syncthreads();
  if (tid < 2) atomicMax((unsigned*)(p.ws + OFF_KMAX) + (l * 34 + (samp ? 32 + seq : seq)) * 2 + tid, lk[tid]);
  {
    int rr = tid >> 1, half = tid & 1;
    int kv = rr >> 6, d = rr & 63;
    u16* dst;
    if (!samp) dst = (u16*)(p.ws + OFF_VTP) + (((size_t)seq * 2 + kv) * 64 + d) * 256 + pos0 + half * 32;
    else dst = (u16*)(p.ws + OFF_VTS) + (((size_t)seq * 2 + kv) * 64 + d) * NKS + 256 + pos0 + half * 32;
#pragma unroll
    for (int i = 0; i < 4; ++i) *(uint4*)(dst + i * 8) = *(const uint4*)(vt + rr * 72 + half * 32 + i * 8);
  }
  __syncthreads();
}

__device__ __forceinline__ void prep_cache_item(const Params& p, int l, int it, u16* sm) {
  const int tid = otid();
  int b = it >> 2, p0 = (it & 3) * 64;
  const float* ck = p.cache_k + (((size_t)b * 2 + l) * 256 + p0) * 128;
  const float* cv = p.cache_v + (((size_t)b * 2 + l) * 256 + p0) * 128;
  u16* vt = sm;
  {
    int tl = tid >> 2, part = tid & 3, kv = part >> 1, d0 = (part & 1) * 32;
    const float* src = ck + tl * 128 + kv * 64 + d0;
    u16* dst = (u16*)(p.ws + OFF_KS) + (((size_t)b * 2 + kv) * NKS + p0 + tl) * 64 + d0;
    float k2 = 0.f;
#pragma unroll
    for (int i = 0; i < 4; ++i) {
      float4 a = *(const float4*)(src + 8 * i), c4 = *(const float4*)(src + 8 * i + 4);
      k2 += a.x * a.x + a.y * a.y + a.z * a.z + a.w * a.w + c4.x * c4.x + c4.y * c4.y + c4.z * c4.z + c4.w * c4.w;
      uint4 o; o.x = pk2(a.x, a.y); o.y = pk2(a.z, a.w); o.z = pk2(c4.x, c4.y); o.w = pk2(c4.z, c4.w);
      *(uint4*)(dst + 8 * i) = o;
    }
    k2 += __shfl_xor(k2, 1);
    if ((part & 1) == 0) atomicMax((unsigned*)(p.ws + OFF_KMAX) + (l * 34 + 32 + b) * 2 + kv, __float_as_uint(k2));
  }
  for (int idx = tid; idx < 64 * 128; idx += 256) {
    int tl = idx >> 7, cc = idx & 127;
    vt[cc * 72 + tl] = f2bf(cv[idx]);
  }
  __syncthreads();
  {
    int rr = tid >> 1, half = tid & 1;
    int kv = rr >> 6, d = rr & 63;
    u16* dst = (u16*)(p.ws + OFF_VTS) + (((size_t)b * 2 + kv) * 64 + d) * NKS + p0 + half * 32;
#pragma unroll
    for (int i = 0; i < 4; ++i) *(uint4*)(dst + i * 8) = *(const uint4*)(vt + rr * 72 + half * 32 + i * 8);
  }
  __syncthreads();
}

__device__ __forceinline__ void prep_hy_item(const Params& p, int l, int it) {
  const int c = otid();
  const int t0 = it * 32;
  const u16* proj = (const u16*)(p.ws + OFF_PROJ);
  u16* ut = (u16*)(p.ws + OFF_UB) + (size_t)c * TT + t0;
  u16* xt = (u16*)(p.ws + OFF_X0) + (size_t)c * TT + t0;
  int L = t0 < TP ? LP : LS;
  int pos0 = t0 < TP ? (t0 & 255) : ((t0 - TP) & 4095);
  const float* cw = p.hy_conv_w + l * 3 * 768;
  const float* cb = p.hy_conv_b + l * 768;
  float w0[3], w1[3], w2[3], bb[3];
#pragma unroll
  for (int s = 0; s < 3; ++s) {
    w0[s] = cw[0 * 768 + s * 256 + c]; w1[s] = cw[1 * 768 + s * 256 + c]; w2[s] = cw[2 * 768 + s * 256 + c];
    bb[s] = cb[s * 256 + c];
  }
  float prev[3], cur[3], nxt[3];
#pragma unroll
  for (int s = 0; s < 3; ++s) {
    prev[s] = pos0 > 0 ? bf2f(proj[(size_t)(t0 - 1) * INW + 768 + s * 256 + c]) : 0.f;
    cur[s] = bf2f(proj[(size_t)t0 * INW + 768 + s * 256 + c]);
  }
  for (int t8 = 0; t8 < 32; t8 += 8) {
    float uv[8], xv[8];
#pragma unroll
    for (int q = 0; q < 8; ++q) {
      int tl = t8 + q;
      int tok = t0 + tl;
      bool has_next = (pos0 + tl + 1) < L;
      float z[3];
#pragma unroll
      for (int s = 0; s < 3; ++s) {
        nxt[s] = has_next ? bf2f(proj[(size_t)(tok + 1) * INW + 768 + s * 256 + c]) : 0.f;
        z[s] = prev[s] * w0[s] + cur[s] * w1[s] + nxt[s] * w2[s] + bb[s];
        prev[s] = cur[s]; cur[s] = nxt[s];
      }
      xv[q] = z[0];
      uv[q] = z[1] * z[2];
    }
    uint4 o; o.x = pk2(uv[0], uv[1]); o.y = pk2(uv[2], uv[3]); o.z = pk2(uv[4], uv[5]); o.w = pk2(uv[6], uv[7]);
    *(uint4*)(ut + t8) = o;
    o.x = pk2(xv[0], xv[1]); o.y = pk2(xv[2], xv[3]); o.z = pk2(xv[4], xv[5]); o.w = pk2(xv[6], xv[7]);
    *(uint4*)(xt + t8) = o;
  }
}

__device__ __forceinline__ void prep_sg_item(const Params& p, int l, int it) {
  const int lane = otid() & 63, w = otid() >> 6;
  const int tok0 = it * 16 + w * 4;
  const u16* src = (const u16*)(p.ws + OFF_PROJ) + (size_t)tok0 * INW + 1536;
  uint2 uu[4], vv[4];
#pragma unroll
  for (int q = 0; q < 4; ++q) {
    uu[q] = *(const uint2*)(src + (size_t)q * INW + lane * 4);
    vv[q] = *(const uint2*)(src + (size_t)q * INW + 256 + lane * 4);
  }
  const float* g = p.sg_norm_g + l * 256 + lane * 4;
  const float4 gq = *(const float4*)g;
#pragma unroll
  for (int q = 0; q < 4; ++q) {
    float u[4] = {__uint_as_float(uu[q].x << 16), __uint_as_float(uu[q].x & 0xFFFF0000u), __uint_as_float(uu[q].y << 16), __uint_as_float(uu[q].y & 0xFFFF0000u)};
    float v[4] = {__uint_as_float(vv[q].x << 16), __uint_as_float(vv[q].x & 0xFFFF0000u), __uint_as_float(vv[q].y << 16), __uint_as_float(vv[q].y & 0xFFFF0000u)};
    float ss = 0.f;
#pragma unroll
    for (int i = 0; i < 4; ++i) { u[i] = gelu_t(u[i]); v[i] = gelu_t(v[i]); ss += v[i] * v[i]; }
    ss = wave_sum(ss);
    float rstd = rsqrtf(ss * (1.0f / 256.0f) + 1e-6f);
    uint2 ou, ov;
    ou.x = pk2(u[0], u[1]); ou.y = pk2(u[2], u[3]);
    ov.x = pk2(v[0] * rstd * gq.x, v[1] * rstd * gq.y); ov.y = pk2(v[2] * rstd * gq.z, v[3] * rstd * gq.w);
    *(uint2*)((u16*)(p.ws + OFF_UG) + (size_t)(tok0 + q) * 256 + lane * 4) = ou;
    *(uint2*)((u16*)(p.ws + OFF_VGN) + (size_t)(tok0 + q) * 256 + lane * 4) = ov;
  }
}

constexpr int P3_QKV = 256, P3_CACHE = 8, P3_HY = 512, P3_SG = 1024;
__device__ __forceinline__ void phase_prep(const Params& p, int l, u16* sm) {
  const int total = P3_QKV + P3_CACHE + P3_HY + P3_SG;
  for (int it0 = obid(); it0 < total; it0 += gridDim.x) {
    int it = it0;
    if (it < P3_QKV) { prep_qkv_item(p, l, it, sm); continue; }
    it -= P3_QKV;
    if (it < P3_CACHE) { prep_cache_item(p, l, it, sm); continue; }
    it -= P3_CACHE;
    if (it < P3_HY) { prep_hy_item(p, l, it); continue; }
    it -= P3_HY;
    prep_sg_item(p, l, it);
  }
}

__device__ __forceinline__ void attn_tile(const u16* Ksb, const u16* Vsb, const u16* Qs, const float (&negm)[2], f32x16 (&o)[2][2],
                                          f32x2 (&ls2)[2], int r, int hw) {
  f32x16 s[2][2];
#pragma unroll
  for (int qt = 0; qt < 2; ++qt)
#pragma unroll
    for (int e = 0; e < 16; ++e) { s[qt][0][e] = negm[qt]; s[qt][1][e] = negm[qt]; }
#pragma unroll
  for (int ks = 0; ks < 4; ++ks) {
    bf16x8 k0 = *(const bf16x8*)(Ksb + r * 72 + ks * 16 + hw * 8);
    bf16x8 k1 = *(const bf16x8*)(Ksb + (32 + r) * 72 + ks * 16 + hw * 8);
    bf16x8 q0 = *(const bf16x8*)(Qs + r * 72 + ks * 16 + hw * 8);
    bf16x8 q1 = *(const bf16x8*)(Qs + (32 + r) * 72 + ks * 16 + hw * 8);
    s[0][0] = MFMA32(k0, q0, s[0][0]);
    s[1][0] = MFMA32(k0, q1, s[1][0]);
    s[0][1] = MFMA32(k1, q0, s[0][1]);
    s[1][1] = MFMA32(k1, q1, s[1][1]);
  }
#pragma unroll
  for (int qt = 0; qt < 2; ++qt) {
#pragma unroll
    for (int e = 0; e < 16; ++e) {
      s[qt][0][e] = __builtin_amdgcn_exp2f(s[qt][0][e]);
      s[qt][1][e] = __builtin_amdgcn_exp2f(s[qt][1][e]);
    }
#pragma unroll
    for (int e = 0; e < 16; e += 2) {
      ls2[qt] += (f32x2){s[qt][0][e], s[qt][0][e + 1]};
      ls2[qt] += (f32x2){s[qt][1][e], s[qt][1][e + 1]};
    }
  }
#pragma unroll
  for (int j = 0; j < 4; ++j) {
    const int mt = j >> 1, rb = (j & 1) * 8;
    union { bf16x8 v; unsigned u[4]; } pb0, pb1;
#pragma unroll
    for (int q = 0; q < 4; ++q) {
      pb0.u[q] = pk2(s[0][mt][rb + 2 * q], s[0][mt][rb + 2 * q + 1]);
      pb1.u[q] = pk2(s[1][mt][rb + 2 * q], s[1][mt][rb + 2 * q + 1]);
    }
#pragma unroll
    for (int dt = 0; dt < 2; ++dt) {
      union { bf16x8 v; uint2 h[2]; } va;
      const u16* vp = Vsb + (dt * 32 + r) * 72 + j * 16 + hw * 4;
      va.h[0] = *(const uint2*)(vp);
      va.h[1] = *(const uint2*)(vp + 8);
      o[0][dt] = MFMA32(va.v, pb0.v, o[0][dt]);
      o[1][dt] = MFMA32(va.v, pb1.v, o[1][dt]);
    }
  }
}

__device__ __forceinline__ void attn_item(const u16* qbase  , const u16* K, const u16* Vt, int ldv, int nk,
                          float kmax2  , u16* obase  , u16* sm) {
  const int tid = otid(), lane = tid & 63, w = tid >> 6, hw = lane >> 5, r = lane & 31;
  u16* Ks = sm;
  u16* Vs = sm + 64 * 72;
  u16* Qs = sm + 2 * 64 * 72 + w * (64 * 72);
  const int nt = nk / 64;
  const int lrow = tid >> 3, lcc = tid & 7;
  const u16* Kg = K + (size_t)lrow * 64 + lcc * 8;
  const u16* Vg = Vt + (size_t)lrow * ldv + lcc * 8;
  uint4 rk0 = *(const uint4*)(Kg), rk1 = *(const uint4*)(Kg + 32 * 64);
  uint4 rv0 = *(const uint4*)(Vg), rv1 = *(const uint4*)(Vg + (size_t)32 * ldv);
#pragma unroll
  for (int i = 0; i < 8; ++i) {
    const int id = lane + 64 * i, row = id >> 3, cc = id & 7;
    *(uint4*)(Qs + row * 72 + cc * 8) = *(const uint4*)(qbase + (size_t)(w * 64 + row) * 512 + cc * 8);
  }
  __syncthreads();
  float negm[2];
#pragma unroll
  for (int qt = 0; qt < 2; ++qt) {
    float q2 = 0.f;
#pragma unroll
    for (int ks = 0; ks < 4; ++ks) {
      bf16x8 qv8 = *(const bf16x8*)(Qs + (qt * 32 + r) * 72 + ks * 16 + hw * 8);
#pragma unroll
      for (int j = 0; j < 8; ++j) { float qv = bf2f((u16)qv8[j]); q2 += qv * qv; }
    }
    q2 += __shfl_xor(q2, 32);
    negm[qt] = -sqrtf(q2 * kmax2) * 1.004f;
  }
  f32x16 o[2][2];
#pragma unroll
  for (int e = 0; e < 16; ++e) { o[0][0][e] = 0.f; o[0][1][e] = 0.f; o[1][0][e] = 0.f; o[1][1][e] = 0.f; }
  f32x2 ls2[2] = {{0.f, 0.f}, {0.f, 0.f}};
  u16* Kw = Ks + lrow * 72 + lcc * 8;
  u16* Vw = Vs + lrow * 72 + lcc * 8;
  for (int kt = 0; kt < nt; ++kt) {
    __syncthreads();
    *(uint4*)(Kw) = rk0; *(uint4*)(Kw + 32 * 72) = rk1;
    *(uint4*)(Vw) = rv0; *(uint4*)(Vw + 32 * 72) = rv1;
    __syncthreads();
    if (kt + 1 < nt) {
      const u16* Kg2 = Kg + (size_t)(kt + 1) * 64 * 64;
      const u16* Vg2 = Vg + (kt + 1) * 64;
      rk0 = *(const uint4*)(Kg2); rk1 = *(const uint4*)(Kg2 + 32 * 64);
      rv0 = *(const uint4*)(Vg2); rv1 = *(const uint4*)(Vg2 + (size_t)32 * ldv);
    }
    attn_tile(Ks, Vs, Qs, negm, o, ls2, r, hw);
  }
#pragma unroll
  for (int qt = 0; qt < 2; ++qt) {
    float lsum = ls2[qt][0] + ls2[qt][1];
    float lt = lsum + __shfl_xor(lsum, 32);
    float inv = 1.0f / lt;
    u16* orow = obase + (size_t)(w * 64 + qt * 32 + r) * DM;
#pragma unroll
    for (int dt = 0; dt < 2; ++dt)
#pragma unroll
      for (int rg = 0; rg < 4; ++rg) {
        uint2 ov;
        ov.x = pk2(o[qt][dt][rg * 4 + 0] * inv, o[qt][dt][rg * 4 + 1] * inv);
        ov.y = pk2(o[qt][dt][rg * 4 + 2] * inv, o[qt][dt][rg * 4 + 3] * inv);
        *(uint2*)(orow + dt * 32 + rg * 8 + hw * 4) = ov;
      }
  }
  __syncthreads();
}

__device__ __forceinline__ void hy_sample_item(const Params& p, int l, int c, float* smf) {
  const int tid = otid(), lane = tid & 63, w = tid >> 6;
  u16* R = (u16*)smf;
  u16* U = R + 8208;
  const u16* hf = (const u16*)(p.ws + OFF_HFS) + ((size_t)l * 256 + c) * HFS_STRIDE;
  for (int i = tid; i < 8208 / 8; i += 256) *(uint4*)(R + i * 8) = *(const uint4*)(hf + i * 8);
  const u16* utb = (const u16*)(p.ws + OFF_UB) + (size_t)c * TT + TP;
  for (int i = tid; i < 2 * 522; i += 256) {
    int b = i / 522, q = i % 522;
    int s = q * 8 - 32;
    uint4 v = make_uint4(0u, 0u, 0u, 0u);
    if (s >= 0 && s < 4096) v = *(const uint4*)(utb + b * 4096 + s);
    *(uint4*)(U + b * 4176 + q * 8) = v;
  }
  __syncthreads();
  const int n = lane & 15, kq = lane >> 4;
  f32x4 acc[4][2];
#pragma unroll
  for (int ii = 0; ii < 4; ++ii)
#pragma unroll
    for (int b = 0; b < 2; ++b) acc[ii][b] = (f32x4){0.f, 0.f, 0.f, 0.f};
  const u16* Ra = R + 4112 - 256 * (4 * w) - 16 * n + 8 * kq;
  const u16* Ub0 = U + 32 + 8 * kq + n;
  for (int s0 = -32; s0 <= 4064; s0 += 32) {
    union { bf16x8 v; unsigned u[4]; } b0, b1;
    const u16* up = Ub0 + s0;
#pragma unroll
    for (int j = 0; j < 4; ++j) {
      b0.u[j] = (unsigned)up[2 * j] | ((unsigned)up[2 * j + 1] << 16);
      b1.u[j] = (unsigned)up[4176 + 2 * j] | ((unsigned)up[4176 + 2 * j + 1] << 16);
    }
#pragma unroll
    for (int ii = 0; ii < 4; ++ii) {
      bf16x8 a = *(const bf16x8*)(Ra + s0 - 256 * ii);
      acc[ii][0] = __builtin_amdgcn_mfma_f32_16x16x32_bf16(a, b0.v, acc[ii][0], 0, 0, 0);
      acc[ii][1] = __builtin_amdgcn_mfma_f32_16x16x32_bf16(a, b1.v, acc[ii][1], 0, 0, 0);
    }
  }
  float skip = p.hy_skip[l * 256 + c];
  const u16* xt = (const u16*)(p.ws + OFF_X0) + (size_t)c * TT + TP;
  u16* mix = (u16*)(p.ws + OFF_MIX);
#pragma unroll
  for (int ii = 0; ii < 4; ++ii)
#pragma unroll
    for (int b = 0; b < 2; ++b)
#pragma unroll
      for (int r = 0; r < 4; ++r) {
        int t = 256 * (4 * w + ii) + 16 * (4 * kq + r) + n;
        size_t tok = (size_t)TP + b * LS + t;
        float y = bf2f(xt[b * LS + t]) * (acc[ii][b][r] + bf2f(U[b * 4176 + 32 + t]) * skip);
        mix[tok * DM + 512 + c] = f2bf(y);
      }
  __syncthreads();
}

__device__ __forceinline__ void hy_prompt_item(const Params& p, int l, int c, float* smf) {
  const int tid = otid(), lane = tid & 63, w = tid >> 6;
  u16* R = (u16*)smf;
  u16* U = R + 544;
  const u16* hf = (const u16*)(p.ws + OFF_HFP) + ((size_t)l * 256 + c) * HFP_STRIDE;
  if (tid < 528 / 8) *(uint4*)(R + tid * 8) = *(const uint4*)(hf + tid * 8);
  const u16* ut = (const u16*)(p.ws + OFF_UB) + (size_t)c * TT;
  for (int i = tid; i < 32 * 42; i += 256) {
    int b = i / 42, q = i % 42;
    int s = q * 8 - 32;
    uint4 v = make_uint4(0u, 0u, 0u, 0u);
    if (s >= 0 && s < 256) v = *(const uint4*)(ut + b * 256 + s);
    *(uint4*)(U + b * 336 + q * 8) = v;
  }
  __syncthreads();
  const int n = lane & 15, kq = lane >> 4;
  bf16x8 af[9];
#pragma unroll
  for (int j = 0; j < 9; ++j) af[j] = *(const bf16x8*)(R + 272 + (-32 + 32 * j) - 16 * n + 8 * kq);
  float skip = p.hy_skip[l * 256 + c];
  const u16* xt = (const u16*)(p.ws + OFF_X0) + (size_t)c * TT;
  u16* mix = (u16*)(p.ws + OFF_MIX);
  for (int bb = 0; bb < 8; ++bb) {
    const int b = w * 8 + bb;
    f32x4 acc = {0.f, 0.f, 0.f, 0.f};
    const u16* ub0 = U + b * 336 + 8 * kq + n;
#pragma unroll
    for (int j = 0; j < 9; ++j) {
      const u16* up = ub0 + 32 * j;
      union { bf16x8 v; unsigned u[4]; } bf;
#pragma unroll
      for (int q = 0; q < 4; ++q) bf.u[q] = (unsigned)up[2 * q] | ((unsigned)up[2 * q + 1] << 16);
      acc = __builtin_amdgcn_mfma_f32_16x16x32_bf16(af[j], bf.v, acc, 0, 0, 0);
    }
#pragma unroll
    for (int r = 0; r < 4; ++r) {
      int t = 16 * (4 * kq + r) + n;
      size_t tok = (size_t)b * 256 + t;
      float y = bf2f(xt[tok]) * (acc[r] + bf2f(U[b * 336 + 32 + t]) * skip);
      mix[tok * DM + 512 + c] = f2bf(y);
    }
  }
  __syncthreads();
}

__device__ __forceinline__ void sg_item(const Params& p, int l, int it, u16* sm) {
  const int tid = otid(), lane = tid & 63, w = tid >> 6, hw = lane >> 5, r = lane & 31;
  const int chunk = it >> 2, h = it & 3;
  const int tok0 = chunk * 128;
  u16* Bs = sm;
  const u16* vgn = (const u16*)(p.ws + OFF_VGN);
#pragma unroll
  for (int i = 0; i < 4; ++i) {
    int id = tid + 256 * i, q = id >> 3, cc = id & 7;
    uint4 v = *(const uint4*)(vgn + (size_t)(tok0 + q) * 256 + h * 64 + cc * 8);
    unsigned wv[4] = {v.x, v.y, v.z, v.w};
#pragma unroll
    for (int j = 0; j < 4; ++j) {
      Bs[(cc * 8 + 2 * j) * 136 + q] = (u16)(wv[j] & 0xFFFFu);
      Bs[(cc * 8 + 2 * j + 1) * 136 + q] = (u16)(wv[j] >> 16);
    }
  }
  __syncthreads();
  const u16* wsb = (const u16*)(p.ws + OFF_WSB) + ((size_t)(l * 4 + h) * 128) * 128;
  f32x16 acc[2];
#pragma unroll
  for (int e = 0; e < 16; ++e) { acc[0][e] = 0.f; acc[1][e] = 0.f; }
#pragma unroll
  for (int ks = 0; ks < 8; ++ks) {
    bf16x8 a = *(const bf16x8*)(wsb + (size_t)(w * 32 + r) * 128 + ks * 16 + hw * 8);
    bf16x8 b0 = *(const bf16x8*)(Bs + r * 136 + ks * 16 + hw * 8);
    bf16x8 b1 = *(const bf16x8*)(Bs + (32 + r) * 136 + ks * 16 + hw * 8);
    acc[0] = MFMA32(a, b0, acc[0]);
    acc[1] = MFMA32(a, b1, acc[1]);
  }
  const u16* ug = (const u16*)(p.ws + OFF_UG);
  u16* mix = (u16*)(p.ws + OFF_MIX);
  const float* sb = p.sg_b + (l * 4 + h) * 128;
#pragma unroll
  for (int nt = 0; nt < 2; ++nt)
#pragma unroll
    for (int e = 0; e < 16; ++e) {
      int pp = w * 32 + (e & 3) + 8 * (e >> 2) + 4 * hw;
      int cc = nt * 32 + r;
      size_t tok = (size_t)tok0 + pp;
      float val = (acc[nt][e] + sb[pp]) * bf2f(ug[tok * 256 + h * 64 + cc]);
      mix[tok * DM + 768 + h * 64 + cc] = f2bf(val);
    }
  __syncthreads();
}

__device__ __forceinline__ void tab_item(const Params& p, int it) {
  const int tid = otid();
      int tab = it >> 11, r = it & 2047;
      const float* src = (tab ? p.peer_v : p.peer_u) + (size_t)r * 16384 + tid * 16;
      unsigned char* dst = (unsigned char*)(p.ws + (tab ? OFF_VT : OFF_UT)) + (size_t)r * 16384 + tid * 16;
      const float scl = tab ? 64.0f : 256.0f;
      f32x4 f[4][4];
#pragma unroll
      for (int q = 0; q < 4; ++q)
#pragma unroll
        for (int j = 0; j < 4; ++j) f[q][j] = __builtin_nontemporal_load((const f32x4*)(src + q * 4096 + j * 4));
#pragma unroll
      for (int q = 0; q < 4; ++q) {
        unsigned ow[4];
#pragma unroll
        for (int j = 0; j < 4; ++j) {
          int t = __builtin_amdgcn_cvt_pk_fp8_f32(f[q][j][0] * scl, f[q][j][1] * scl, 0, false);
          t = __builtin_amdgcn_cvt_pk_fp8_f32(f[q][j][2] * scl, f[q][j][3] * scl, t, true);
          ow[j] = (unsigned)t;
        }
        *(uint4*)(dst + q * 4096) = make_uint4(ow[0], ow[1], ow[2], ow[3]);
      }
}

constexpr int P4_AS = 256, P4_HS = 256, P4_HP = 256, P4_AP = 256, P4_SG = 512;
__device__ __forceinline__ void phase_mix(const Params& p, int l, u16* sm) {
  const int total = P4_AS + P4_HS + P4_HP + P4_AP + P4_SG;
  if (l == 0 && (obid() & 1)) for (int it = obid(); it < P0_TAB; it += gridDim.x) tab_item(p, it);
  const u16* qn = (const u16*)(p.ws + OFF_QN);
  u16* mix = (u16*)(p.ws + OFF_MIX);
  const bool bias = (gridDim.x == 512);
  const int main_items = P4_AS + P4_HS;
  for (int step = 0; ; ++step) {
    int it0;
    if (!bias) { it0 = obid() + step * (int)gridDim.x; if (it0 >= total) break; }
    else {
      const int bid = obid();
      if (step == 0) it0 = bid;
      else if (bid >= 256) { if (step >= 3) break; it0 = main_items + (bid - 256) + (step - 1) * 256; }
      else { if (step >= 3) break; it0 = main_items + 512 + bid + (step - 1) * 256; }
    }
    int it = it0;
    if (it < P4_AS) {
      int b = it >> 7, rr = it & 127, head = rr >> 4, qb = rr & 15;
      int kv = head >> 2;
      size_t tok0 = (size_t)TP + b * LS + qb * 256;
      attn_item(qn + tok0 * 512 + head * 64, (const u16*)(p.ws + OFF_KS) + ((size_t)b * 2 + kv) * NKS * 64,
                (const u16*)(p.ws + OFF_VTS) + ((size_t)b * 2 + kv) * 64 * NKS, NKS, NKS,
                ((const float*)(p.ws + OFF_KMAX))[(l * 34 + 32 + b) * 2 + kv], mix + tok0 * DM + head * 64, sm);
      continue;
    }
    it -= P4_AS;
    if (it < P4_HS) { hy_sample_item(p, l, it, (float*)sm); continue; }
    it -= P4_HS;
    if (it < P4_HP) { hy_prompt_item(p, l, it, (float*)sm); continue; }
    it -= P4_HP;
    if (it < P4_AP) {
      int b = it >> 3, head = it & 7;
      int kv = head >> 2;
      size_t tok0 = (size_t)b * 256;
      attn_item(qn + tok0 * 512 + head * 64, (const u16*)(p.ws + OFF_KP) + ((size_t)b * 2 + kv) * 256 * 64,
                (const u16*)(p.ws + OFF_VTP) + ((size_t)b * 2 + kv) * 64 * 256, 256, 256,
                ((const float*)(p.ws + OFF_KMAX))[(l * 34 + b) * 2 + kv], mix + tok0 * DM + head * 64, sm);
      continue;
    }
    it -= P4_AP;
    sg_item(p, l, it, sm);
  }
  if (l == 0 && !(obid() & 1)) for (int it = obid(); it < P0_TAB; it += gridDim.x) tab_item(p, it);
}

__device__ __forceinline__ unsigned ordf(float f) {
  unsigned b = __float_as_uint(f);
  return (b & 0x80000000u) ? ~b : (b | 0x80000000u);
}
__device__ __forceinline__ float unordf(unsigned k) {
  unsigned b = (k & 0x80000000u) ? (k & 0x7FFFFFFFu) : ~k;
  return __uint_as_float(b);
}
__device__ __forceinline__ void sort16_desc(unsigned (&a)[16]) {
#pragma unroll
  for (int k = 2; k <= 16; k <<= 1) {
#pragma unroll
    for (int j = k >> 1; j > 0; j >>= 1) {
#pragma unroll
      for (int i = 0; i < 16; ++i) {
        int l2 = i ^ j;
        if (l2 > i) {
          bool desc = ((i & k) == 0);
          unsigned x = a[i], y = a[l2];
          unsigned mx = max(x, y), mn = min(x, y);
          a[i] = desc ? mx : mn;
          a[l2] = desc ? mn : mx;
        }
      }
    }
  }
}
__device__ __forceinline__ void merge16_desc(unsigned (&a)[16]) {
#pragma unroll
  for (int j = 8; j > 0; j >>= 1) {
#pragma unroll
    for (int i = 0; i < 16; ++i) {
      int l2 = i ^ j;
      if (l2 > i) {
        unsigned x = a[i], y = a[l2];
        a[i] = max(x, y);
        a[l2] = min(x, y);
      }
    }
  }
}
__device__ __forceinline__ void top16_of_64(const unsigned (&in)[64], unsigned (&T)[16]) {
#pragma unroll
  for (int ch = 0; ch < 4; ++ch) {
    unsigned C[16];
#pragma unroll
    for (int i = 0; i < 16; ++i) C[i] = in[ch * 16 + i];
    sort16_desc(C);
    if (ch == 0) {
#pragma unroll
      for (int i = 0; i < 16; ++i) T[i] = C[i];
    } else {
#pragma unroll
      for (int i = 0; i < 16; ++i) T[i] = max(T[i], C[15 - i]);
      merge16_desc(T);
    }
  }
}

__device__ __forceinline__ void peer_load8(const int* ip, const unsigned char* ut, const unsigned char* vtb, int lane, uint4 (&uu)[8], uint4 (&vv)[8]) {
#pragma unroll
  for (int j = 0; j < 8; ++j) {
    int idx = ip[j];
    uu[j] = *(const uint4*)(ut + (size_t)idx * 1024 + lane * 16);
    vv[j] = *(const uint4*)(vtb + (size_t)idx * 1024 + lane * 16);
  }
}
__device__ __forceinline__ void peer_compute8(const uint4 (&uu)[8], const uint4 (&vv)[8], const f32x2 (&x2)[8], f32x2 (&o2)[8], float gate_me, int lane) {
  float pd[8];
#pragma unroll
  for (int j = 0; j < 8; ++j) {
    unsigned uw[4] = {uu[j].x, uu[j].y, uu[j].z, uu[j].w};
    f32x2 d2 = {0.f, 0.f};
#pragma unroll
    for (int k = 0; k < 4; ++k) {
      f32x2 lo = __builtin_amdgcn_cvt_pk_f32_fp8((int)uw[k], false);
      f32x2 hi = __builtin_amdgcn_cvt_pk_f32_fp8((int)uw[k], true);
      d2 = __builtin_elementwise_fma(lo, x2[2 * k], d2);
      d2 = __builtin_elementwise_fma(hi, x2[2 * k + 1], d2);
    }
    pd[j] = d2[0] + d2[1];
  }
  float q4[4], q2[2], q1;
#pragma unroll
  for (int j = 0; j < 4; ++j) {
    float mine = (lane & 32) ? pd[j + 4] : pd[j];
    float oth = (lane & 32) ? pd[j] : pd[j + 4];
    q4[j] = mine + __shfl_xor(oth, 32);
  }
#pragma unroll
  for (int j = 0; j < 2; ++j) {
    float mine = (lane & 16) ? q4[j + 2] : q4[j];
    float oth = (lane & 16) ? q4[j] : q4[j + 2];
    q2[j] = mine + __shfl_xor(oth, 16);
  }
  {
    float mine = (lane & 8) ? q2[1] : q2[0];
    float oth = (lane & 8) ? q2[0] : q2[1];
    q1 = mine + __shfl_xor(oth, 8);
  }
  q1 += __shfl_xor(q1, 4); q1 += __shfl_xor(q1, 2); q1 += __shfl_xor(q1, 1);
  float a = gelu_t(q1 * (1.0f / 256.0f)) * gate_me * (1.0f / 64.0f);
#pragma unroll
  for (int j = 0; j < 8; ++j) {
    const int src_lane = (j >> 2) * 32 + ((j >> 1) & 1) * 16 + (j & 1) * 8;
    float aj = __uint_as_float((unsigned)__builtin_amdgcn_readlane((int)__float_as_uint(a), src_lane));
    unsigned vw[4] = {vv[j].x, vv[j].y, vv[j].z, vv[j].w};
    f32x2 aj2 = {aj, aj};
#pragma unroll
    for (int k = 0; k < 4; ++k) {
      f32x2 lo = __builtin_amdgcn_cvt_pk_f32_fp8((int)vw[k], false);
      f32x2 hi = __builtin_amdgcn_cvt_pk_f32_fp8((int)vw[k], true);
      o2[2 * k] = __builtin_elementwise_fma(aj2, lo, o2[2 * k]);
      o2[2 * k + 1] = __builtin_elementwise_fma(aj2, hi, o2[2 * k + 1]);
    }
  }
}

__device__ __forceinline__ void peer_item(const Params& p, int l, int it, u16* smraw) {
  const int tid = otid(), lane = tid & 63, w = tid >> 6, hw = lane >> 5, r = lane & 31;
  const int t0 = it * 32;
  int* sidx = (int*)smraw;
  float* sgate = (float*)(smraw) + 32 * 128;
  const u16* qp = (const u16*)(p.ws + OFF_QP);
  const u16* keysb = (const u16*)(p.ws + OFF_KEYS);
  unsigned P[2][16];
  unsigned* stash = (unsigned*)smraw + 8192 + w * 32 + r;
  for (int hh = 0; hh < 2; ++hh) {
    const int h = w * 2 + hh;
#pragma unroll
    for (int pp = 0; pp < 2; ++pp) {
      f32x16 acc[4];
#pragma unroll
      for (int mt = 0; mt < 4; ++mt)
#pragma unroll
        for (int e = 0; e < 16; ++e) acc[mt][e] = 0.f;
      const u16* kb = keysb + ((size_t)((l * 8 + h) * 2 + pp) * 128) * 64;
      const u16* qb = qp + (size_t)(t0 + r) * 1024 + h * 128 + pp * 64;
#pragma unroll
      for (int ks = 0; ks < 4; ++ks) {
        bf16x8 b = *(const bf16x8*)(qb + ks * 16 + hw * 8);
#pragma unroll
        for (int mt = 0; mt < 4; ++mt) {
          bf16x8 a = *(const bf16x8*)(kb + (size_t)(mt * 32 + r) * 64 + ks * 16 + hw * 8);
          acc[mt] = MFMA32(a, b, acc[mt]);
        }
      }
      unsigned in[64];
#pragma unroll
      for (int mt = 0; mt < 4; ++mt)
#pragma unroll
        for (int e = 0; e < 16; ++e) {
          unsigned n = 32 * mt + (e & 3) + 8 * (e >> 2) + 4 * hw;
          in[mt * 16 + e] = (ordf(acc[mt][e]) & ~127u) | n;
        }
      unsigned T[16];
      top16_of_64(in, T);
      unsigned C[16];
#pragma unroll
      for (int i = 0; i < 16; ++i) C[i] = (unsigned)__shfl_xor((int)T[15 - i], 32);
#pragma unroll
      for (int i = 0; i < 16; ++i) T[i] = max(T[i], C[i]);
      merge16_desc(T);
#pragma unroll
      for (int i = 0; i < 16; ++i) P[pp][i] = T[i];
    }
    if (hh == 0 && hw == 0) {
#pragma unroll
      for (int k = 0; k < 32; ++k) stash[k * 128] = P[k >> 4][k & 15];
    }
  }
  if (hw == 0) {
#pragma unroll
    for (int k = 0; k < 32; ++k) P[k >> 4][k & 15] = stash[k * 128];
  }
  {
    const int h = w * 2 + hw;
    float v1[16], v2[16];
#pragma unroll
    for (int i = 0; i < 16; ++i) {
      v1[i] = unordf((P[0][i] & ~127u) | 64u);
      v2[i] = unordf((P[1][i] & ~127u) | 64u);
    }
    unsigned cd[64];
    {
      int n = 0;
#pragma unroll
      for (int a = 0; a < 16; ++a)
#pragma unroll
        for (int b = 0; b < 16; ++b)
          if ((a + 1) * (b + 1) <= 16) {
            cd[n] = (ordf(v1[a] + v2[b]) & ~255u) | (unsigned)(a * 16 + b);
            ++n;
          }
#pragma unroll
      for (int k = 50; k < 64; ++k) cd[k] = 0u;
    }
    unsigned T[16];
    {
#pragma unroll
      for (int ch = 0; ch < 3; ++ch) {
        unsigned C[16];
#pragma unroll
        for (int i = 0; i < 16; ++i) C[i] = cd[ch * 16 + i];
        sort16_desc(C);
        if (ch == 0) {
#pragma unroll
          for (int i = 0; i < 16; ++i) T[i] = C[i];
        } else {
#pragma unroll
          for (int i = 0; i < 16; ++i) T[i] = max(T[i], C[15 - i]);
          merge16_desc(T);
        }
      }
      const unsigned hi2 = max(cd[48], cd[49]), lo2 = min(cd[48], cd[49]);
      T[15] = max(T[15], hi2);
      T[14] = max(T[14], lo2);
      merge16_desc(T);
    }
    float sc[16];
    float mxv;
#pragma unroll
    for (int i = 0; i < 16; ++i) sc[i] = unordf((T[i] & ~255u) | 128u);
    mxv = sc[0];
    float sum = 0.f;
#pragma unroll
    for (int i = 0; i < 16; ++i) { sc[i] = __expf(sc[i] - mxv); sum += sc[i]; }
    float inv = 1.0f / sum;
    {
      unsigned pka[4], pkb[4];
#pragma unroll
      for (int q = 0; q < 4; ++q) {
        pka[q] = (P[0][4 * q] & 127u) | ((P[0][4 * q + 1] & 127u) << 8) | ((P[0][4 * q + 2] & 127u) << 16) | ((P[0][4 * q + 3] & 127u) << 24);
        pkb[q] = (P[1][4 * q] & 127u) | ((P[1][4 * q + 1] & 127u) << 8) | ((P[1][4 * q + 2] & 127u) << 16) | ((P[1][4 * q + 3] & 127u) << 24);
      }
#if PEER_PART
      unsigned eidx[16];
#endif
#pragma unroll
      for (int i = 0; i < 16; ++i) {
        unsigned pos = T[i] & 255u;
        unsigned a = pos >> 4, b = pos & 15u;
        const unsigned wa = (a & 8u) ? ((a & 4u) ? pka[3] : pka[2]) : ((a & 4u) ? pka[1] : pka[0]);
        const unsigned wb = (b & 8u) ? ((b & 4u) ? pkb[3] : pkb[2]) : ((b & 4u) ? pkb[1] : pkb[0]);
        const unsigned ia = (wa >> ((a & 3u) * 8u)) & 127u;
        const unsigned ib = (wb >> ((b & 3u) * 8u)) & 127u;
#if PEER_PART
        eidx[i] = ia * 128u + ib;
#else
        sidx[r * 128 + h * 16 + i] = (int)(ia * 128u + ib);
        sgate[r * 128 + h * 16 + i] = sc[i] * inv;
#endif
      }
#if PEER_PART
      u16* gi = (u16*)(p.ws + OFF_GIDX) + (size_t)(t0 + r) * 128 + h * 16;
      float* gg = (float*)(p.ws + OFF_GGATE) + (size_t)(t0 + r) * 128 + h * 16;
      *(uint4*)(gi) = make_uint4(eidx[0] | (eidx[1] << 16), eidx[2] | (eidx[3] << 16), eidx[4] | (eidx[5] << 16), eidx[6] | (eidx[7] << 16));
      *(uint4*)(gi + 8) = make_uint4(eidx[8] | (eidx[9] << 16), eidx[10] | (eidx[11] << 16), eidx[12] | (eidx[13] << 16), eidx[14] | (eidx[15] << 16));
#pragma unroll
      for (int i = 0; i < 4; ++i) *(float4*)(gg + 4 * i) = make_float4(sc[4 * i] * inv, sc[4 * i + 1] * inv, sc[4 * i + 2] * inv, sc[4 * i + 3] * inv);
#endif
    }
  }
#if PEER_PART
  return;
#endif
  __syncthreads();
  const float* mod = (const float*)(p.ws + OFF_MOD) + l * 3 * 6144;
  const u16* hb = (const u16*)(p.ws + OFF_HBUF);
  const unsigned char* ut = (const unsigned char*)(p.ws + OFF_UT) + (size_t)l * 16384 * 1024;
  const unsigned char* vtb = (const unsigned char*)(p.ws + OFF_VT) + (size_t)l * 16384 * 1024;
  const int me = ((lane >> 5) & 1) * 4 + ((lane >> 4) & 1) * 2 + ((lane >> 3) & 1);
  uint4 uA[8], vA[8], uB[8], vB[8];
  for (int tq = 0; tq < 8; ++tq) {
    const int tl = w * 8 + tq;
    const int tok = t0 + tl;
    float xr[16];
    {
      uint4 h0 = *(const uint4*)(hb + (size_t)tok * DM + lane * 16);
      uint4 h1 = *(const uint4*)(hb + (size_t)tok * DM + lane * 16 + 8);
      unsigned hw4[8] = {h0.x, h0.y, h0.z, h0.w, h1.x, h1.y, h1.z, h1.w};
#pragma unroll
      for (int j = 0; j < 8; ++j) { xr[2 * j] = __uint_as_float(hw4[j] << 16); xr[2 * j + 1] = __uint_as_float(hw4[j] & 0xFFFF0000u); }
    }
    f32x2 x2[8], o2[8];
#pragma unroll
    for (int i = 0; i < 8; ++i) { x2[i] = (f32x2){xr[2 * i], xr[2 * i + 1]}; o2[i] = (f32x2){0.f, 0.f}; }
    if (tq == 0) peer_load8(sidx + tl * 128, ut, vtb, lane, uA, vA);
    for (int g8 = 0; g8 < 16; g8 += 2) {
      peer_load8(sidx + tl * 128 + (g8 + 1) * 8, ut, vtb, lane, uB, vB);
      peer_compute8(uA, vA, x2, o2, sgate[tl * 128 + g8 * 8 + me], lane);
      if (g8 + 2 < 16) peer_load8(sidx + tl * 128 + (g8 + 2) * 8, ut, vtb, lane, uA, vA);
      else if (tq < 7) peer_load8(sidx + (tl + 1) * 128, ut, vtb, lane, uA, vA);
      peer_compute8(uB, vB, x2, o2, sgate[tl * 128 + (g8 + 1) * 8 + me], lane);
    }
    const float* gf = mod + mod_index(tok) * 6144 + 5 * 1024;
    float* orow = p.out + (size_t)tok * DM;
#pragma unroll
    for (int i = 0; i < 4; ++i) {
      int k = lane * 16 + i * 4;
      float4 xv = *(const float4*)(orow + k);
      float4 gv = *(const float4*)(gf + k);
      xv.x += gv.x * o2[i * 2][0]; xv.y += gv.y * o2[i * 2][1];
      xv.z += gv.z * o2[i * 2 + 1][0]; xv.w += gv.w * o2[i * 2 + 1][1];
      *(float4*)(orow + k) = xv;
    }
  }
  if (l == 0) {
    for (int tq = 0; tq < 8; ++tq) {
      const int tok = t0 + w * 8 + tq;
      const float* orow = p.out + (size_t)tok * DM;
      float4 xq[4];
      float ss = 0.f;
#pragma unroll
      for (int i = 0; i < 4; ++i) {
        xq[i] = *(const float4*)(orow + lane * 16 + i * 4);
        ss += xq[i].x * xq[i].x + xq[i].y * xq[i].y + xq[i].z * xq[i].z + xq[i].w * xq[i].w;
      }
      ss = wave_sum(ss);
      const float rstd = rsqrtf(ss * (1.0f / 1024.0f) + 1e-6f);
      const float* g1 = p.norm_mix_g + DM;
      const float* mr = (const float*)(p.ws + OFF_MOD) + 3 * 6144 + mod_index(tok) * 6144;
      u16* hw_ = (u16*)(p.ws + OFF_HBUF) + (size_t)tok * DM;
#pragma unroll
      for (int i = 0; i < 4; ++i) {
        int k = lane * 16 + i * 4;
        float4 gg = *(const float4*)(g1 + k);
        float4 sh = *(const float4*)(mr + k);
        float4 sc = *(const float4*)(mr + 1024 + k);
        uint2 o;
        o.x = pk2(xq[i].x * rstd * gg.x * (1.0f + sc.x) + sh.x, xq[i].y * rstd * gg.y * (1.0f + sc.y) + sh.y);
        o.y = pk2(xq[i].z * rstd * gg.z * (1.0f + sc.z) + sh.z, xq[i].w * rstd * gg.w * (1.0f + sc.w) + sh.w);
        *(uint2*)(hw_ + k) = o;
      }
    }
  }
  __syncthreads();
}


#if PEER_PART
__device__ __forceinline__ void pu_load8(const unsigned* pl, int base, int n, const unsigned char* ut, int lane, uint4 (&uu)[8], unsigned (&pr)[8]) {
#pragma unroll
  for (int j = 0; j < 8; ++j) {
    const int q = base + j;
    pr[j] = pl[q < n ? q : 0] | (q < n ? 0u : 0x80000000u);
    uu[j] = *(const uint4*)(ut + (size_t)(pr[j] & 0xFFFFu) * 1024 + lane * 16);
  }
}
__device__ __forceinline__ void pu_compute8(const uint4 (&uu)[8], const unsigned (&pr)[8], const u16* xs, const float* gs, float* abuf_tile, int lane, int me) {
  float pd[8];
#pragma unroll
  for (int j = 0; j < 8; ++j) {
    const int tl = (pr[j] >> 23) & 15;
    const uint4 xa = *(const uint4*)(xs + tl * 1024 + lane * 16);
    const uint4 xb = *(const uint4*)(xs + tl * 1024 + lane * 16 + 8);
    const unsigned xw[8] = {xa.x, xa.y, xa.z, xa.w, xb.x, xb.y, xb.z, xb.w};
    const unsigned uw[4] = {uu[j].x, uu[j].y, uu[j].z, uu[j].w};
    f32x2 d2 = {0.f, 0.f};
#pragma unroll
    for (int k = 0; k < 4; ++k) {
      f32x2 lo = __builtin_amdgcn_cvt_pk_f32_fp8((int)uw[k], false);
      f32x2 hi = __builtin_amdgcn_cvt_pk_f32_fp8((int)uw[k], true);
      f32x2 x0 = {__uint_as_float(xw[2 * k] << 16), __uint_as_float(xw[2 * k] & 0xFFFF0000u)};
      f32x2 x1 = {__uint_as_float(xw[2 * k + 1] << 16), __uint_as_float(xw[2 * k + 1] & 0xFFFF0000u)};
      d2 = __builtin_elementwise_fma(lo, x0, d2);
      d2 = __builtin_elementwise_fma(hi, x1, d2);
    }
    pd[j] = d2[0] + d2[1];
  }
  float q4[4], q2[2], q1;
#pragma unroll
  for (int j = 0; j < 4; ++j) {
    float mine = (lane & 32) ? pd[j + 4] : pd[j];
    float oth = (lane & 32) ? pd[j] : pd[j + 4];
    q4[j] = mine + __shfl_xor(oth, 32);
  }
#pragma unroll
  for (int j = 0; j < 2; ++j) {
    float mine = (lane & 16) ? q4[j + 2] : q4[j];
    float oth = (lane & 16) ? q4[j] : q4[j + 2];
    q2[j] = mine + __shfl_xor(oth, 16);
  }
  {
    float mine = (lane & 8) ? q2[1] : q2[0];
    float oth = (lane & 8) ? q2[0] : q2[1];
    q1 = mine + __shfl_xor(oth, 8);
  }
  q1 += __shfl_xor(q1, 4); q1 += __shfl_xor(q1, 2); q1 += __shfl_xor(q1, 1);
  unsigned mypr = pr[0];
#pragma unroll
  for (int j = 1; j < 8; ++j) mypr = (me == j) ? pr[j] : mypr;
  if ((lane & 7) == 0 && !(mypr & 0x80000000u)) {
    const int e = (mypr >> 16) & 2047;
    abuf_tile[e] = gelu_t(q1 * (1.0f / 256.0f)) * gs[e] * (1.0f / 64.0f);
  }
}
__device__ __forceinline__ void peer_u_unit(const Params& p, int l, int x, int tile16, u16* sm) {
  const int tid = otid(), lane = tid & 63, w = tid >> 6;
  u16* xs = sm;
  float* gs = (float*)(sm + 16384);
  unsigned* pl = (unsigned*)(sm + 20480);
  int* cnt = (int*)(sm + 24576);
  const int tok0 = tile16 * 16;
  const u16* hb = (const u16*)(p.ws + OFF_HBUF) + (size_t)tok0 * DM;
#pragma unroll
  for (int i = 0; i < 8; ++i) {
    const int ch = tid + 256 * i;
    *(uint4*)(xs + ch * 8) = *(const uint4*)(hb + ch * 8);
  }
  const float* gg = (const float*)(p.ws + OFF_GGATE) + (size_t)tok0 * 128;
#pragma unroll
  for (int i = 0; i < 2; ++i) {
    const int e = (tid + 256 * i) * 4;
    *(float4*)(gs + e) = *(const float4*)(gg + e);
  }
  if (tid == 0) *cnt = 0;
  __syncthreads();
  {
    const uint4 iv = *(const uint4*)((const u16*)(p.ws + OFF_GIDX) + (size_t)tok0 * 128 + tid * 8);
    const unsigned iw[4] = {iv.x, iv.y, iv.z, iv.w};
#pragma unroll
    for (int j = 0; j < 8; ++j) {
      const unsigned idx = (j & 1) ? (iw[j >> 1] >> 16) : (iw[j >> 1] & 0xFFFFu);
      if ((int)(idx >> 11) == x) {
        const int pos = atomicAdd(cnt, 1);
        pl[pos] = ((unsigned)(tid * 8 + j) << 16) | idx;
      }
    }
  }
  __syncthreads();
  const int n = *cnt;
  const unsigned char* ut = (const unsigned char*)(p.ws + OFF_UT) + (size_t)l * 16384 * 1024;
  float* abuf_tile = (float*)(p.ws + OFF_ABUF) + (size_t)tok0 * 128;
  const int me = ((lane >> 5) & 1) * 4 + ((lane >> 4) & 1) * 2 + ((lane >> 3) & 1);
  const int nch = (n + 7) >> 3;
  uint4 uA[8], uB[8];
  unsigned prA[8], prB[8];
  int ck = w;
  if (ck < nch) pu_load8(pl, ck * 8, n, ut, lane, uA, prA);
  while (ck < nch) {
    int nk = ck + 4;
    if (nk < nch) pu_load8(pl, nk * 8, n, ut, lane, uB, prB);
    pu_compute8(uA, prA, xs, gs, abuf_tile, lane, me);
    ck = nk;
    if (ck >= nch) break;
    nk = ck + 4;
    if (nk < nch) pu_load8(pl, nk * 8, n, ut, lane, uA, prA);
    pu_compute8(uB, prB, xs, gs, abuf_tile, lane, me);
    ck = nk;
  }
  __syncthreads();
}
__device__ __forceinline__ void phase_peer_u(const Params& p, int l, int xcc, u16* sm) {
  unsigned* qh = (unsigned*)(p.ws + OFF_QHEAD) + l * 8;
  volatile int* bc = (volatile int*)(sm + 24580);
  for (int pr = 0; pr < 8; ++pr) {
    const int x = (xcc + pr) & 7;
    for (;;) {
      if (otid() == 0) bc[0] = (int)atomicAdd(qh + x, 1u);
      __syncthreads();
      const int tile = bc[0];
      __syncthreads();
      if (tile >= TT / 16) break;
      peer_u_unit(p, l, x, tile, sm);
    }
  }
}

__device__ __forceinline__ void pv_load8(const u16* gi, const unsigned char* vtb, int lane, uint4 (&vv)[8]) {
  const uint4 iv = *(const uint4*)gi;
  const unsigned iw[4] = {iv.x, iv.y, iv.z, iv.w};
#pragma unroll
  for (int j = 0; j < 8; ++j) {
    const unsigned idx = (j & 1) ? (iw[j >> 1] >> 16) : (iw[j >> 1] & 0xFFFFu);
    vv[j] = *(const uint4*)(vtb + (size_t)idx * 1024 + lane * 16);
  }
}
__device__ __forceinline__ void pv_compute8(const uint4 (&vv)[8], const float* ap, f32x2 (&o2)[8]) {
  const float4 a0 = *(const float4*)ap, a1 = *(const float4*)(ap + 4);
  const float av[8] = {a0.x, a0.y, a0.z, a0.w, a1.x, a1.y, a1.z, a1.w};
#pragma unroll
  for (int j = 0; j < 8; ++j) {
    const unsigned vw[4] = {vv[j].x, vv[j].y, vv[j].z, vv[j].w};
    const f32x2 aj2 = {av[j], av[j]};
#pragma unroll
    for (int k = 0; k < 4; ++k) {
      f32x2 lo = __builtin_amdgcn_cvt_pk_f32_fp8((int)vw[k], false);
      f32x2 hi = __builtin_amdgcn_cvt_pk_f32_fp8((int)vw[k], true);
      o2[2 * k] = __builtin_elementwise_fma(aj2, lo, o2[2 * k]);
      o2[2 * k + 1] = __builtin_elementwise_fma(aj2, hi, o2[2 * k + 1]);
    }
  }
}
__device__ __forceinline__ void peer_v_item(const Params& p, int l, int it) {
  const int tid = otid(), lane = tid & 63, w = tid >> 6;
  const int t0 = it * 32;
  const unsigned char* vtb = (const unsigned char*)(p.ws + OFF_VT) + (size_t)l * 16384 * 1024;
  const u16* gidx = (const u16*)(p.ws + OFF_GIDX);
  const float* abuf = (const float*)(p.ws + OFF_ABUF);
  const float* mod = (const float*)(p.ws + OFF_MOD) + l * 3 * 6144;
  uint4 vA[8], vB[8];
  for (int tq = 0; tq < 8; ++tq) {
    const int tok = t0 + w * 8 + tq;
    const u16* gi = gidx + (size_t)tok * 128;
    const float* ap = abuf + (size_t)tok * 128;
    f32x2 o2[8];
#pragma unroll
    for (int i = 0; i < 8; ++i) o2[i] = (f32x2){0.f, 0.f};
    if (tq == 0) pv_load8(gi, vtb, lane, vA);
    for (int g8 = 0; g8 < 16; g8 += 2) {
      pv_load8(gi + (g8 + 1) * 8, vtb, lane, vB);
      pv_compute8(vA, ap + g8 * 8, o2);
      if (g8 + 2 < 16) pv_load8(gi + (g8 + 2) * 8, vtb, lane, vA);
      else if (tq < 7) pv_load8(gi + 128, vtb, lane, vA);
      pv_compute8(vB, ap + (g8 + 1) * 8, o2);
    }
    const float* gf = mod + mod_index(tok) * 6144 + 5 * 1024;
    float* orow = p.out + (size_t)tok * DM;
    float ssq = 0.f;
    float4 xf[4];
#pragma unroll
    for (int i = 0; i < 4; ++i) {
      int k = lane * 16 + i * 4;
      float4 xv = *(const float4*)(orow + k);
      float4 gv = *(const float4*)(gf + k);
      xv.x += gv.x * o2[i * 2][0]; xv.y += gv.y * o2[i * 2][1];
      xv.z += gv.z * o2[i * 2 + 1][0]; xv.w += gv.w * o2[i * 2 + 1][1];
      *(float4*)(orow + k) = xv;
      xf[i] = xv;
      ssq += xv.x * xv.x + xv.y * xv.y + xv.z * xv.z + xv.w * xv.w;
    }
    if (l == 0) {
      const float ss = wave_sum(ssq);
      const float rstd = rsqrtf(ss * (1.0f / 1024.0f) + 1e-6f);
      const float* g1 = p.norm_mix_g + DM;
      const float* mr = (const float*)(p.ws + OFF_MOD) + 3 * 6144 + mod_index(tok) * 6144;
      u16* hw_ = (u16*)(p.ws + OFF_HBUF) + (size_t)tok * DM;
#pragma unroll
      for (int i = 0; i < 4; ++i) {
        int k = lane * 16 + i * 4;
        float4 gg = *(const float4*)(g1 + k);
        float4 sh = *(const float4*)(mr + k);
        float4 sc = *(const float4*)(mr + 1024 + k);
        uint2 o;
        o.x = pk2(xf[i].x * rstd * gg.x * (1.0f + sc.x) + sh.x, xf[i].y * rstd * gg.y * (1.0f + sc.y) + sh.y);
        o.y = pk2(xf[i].z * rstd * gg.z * (1.0f + sc.z) + sh.z, xf[i].w * rstd * gg.w * (1.0f + sc.w) + sh.w);
        *(uint2*)(hw_ + k) = o;
      }
    }
  }
}
__device__ __forceinline__ void phase_peer_v(const Params& p, int l) {
  for (int it = obid(); it < TT / 32; it += gridDim.x) peer_v_item(p, l, it);
}
#endif

__device__ __forceinline__ void phase_peer(const Params& p, int l, u16* sm) {
  for (int it = obid(); it < TT / 32; it += gridDim.x) peer_item(p, l, it, sm);
}

#define XB_TMO      128
#define XB_XCNT(j)  (256  + 64 * (j))
#define XB_XSUB(j)  (1280 + 64 * (j))
#define XB_XGEN(j)  (2304 + 64 * (j))
#define XB_TOP      3328
#define XB_TOPGEN   3392
#define XCD_BAR_WORDS 3456
#define XB_SPIN_CAP (1u << 18)
#define LAS __attribute__((address_space(3)))

__device__ __forceinline__ unsigned xb_ld(unsigned* p)              { return __hip_atomic_load(p, __ATOMIC_RELAXED, __HIP_MEMORY_SCOPE_AGENT); }
__device__ __forceinline__ unsigned xb_add(unsigned* p, unsigned v) { return __hip_atomic_fetch_add(p, v, __ATOMIC_RELAXED, __HIP_MEMORY_SCOPE_AGENT); }
__device__ __forceinline__ unsigned xb_xcc_id() { return (unsigned)__builtin_amdgcn_s_getreg((3 << 11) | 20) & 0xFu; }
#define XB_SPIN(cond, bar) do { unsigned _sp = 0; while (cond) { __builtin_amdgcn_s_sleep(1); \
    if ((++_sp & 255u) == 0u) { if (xb_ld(&(bar)[XB_TMO])) break; if (_sp > XB_SPIN_CAP) { atomicAdd(&(bar)[XB_TMO], 1u); break; } } } } while (0)

struct XcdBarrier {
    unsigned* bar; unsigned x;
    volatile LAS unsigned* st;
};

__device__ __forceinline__ XcdBarrier xcd_barrier_post(unsigned* bar, volatile LAS unsigned* st) {
    XcdBarrier b; b.bar = bar; b.x = xb_xcc_id(); b.st = st;
    if (threadIdx.x == 0) (void)xb_add(&bar[XB_XCNT(b.x)], 1u);
    return b;
}
__device__ __forceinline__ void xcd_barrier_complete(unsigned* bar, unsigned x, unsigned& nloc, unsigned& nx) {
    const unsigned G = gridDim.x * gridDim.y * gridDim.z;
    unsigned sum, cnt, mine, sp = 0u;
    for (;;) {
        sum = 0u; cnt = 0u; mine = 0u;
#pragma unroll
        for (unsigned j = 0; j < 16; ++j) { const unsigned c = xb_ld(&bar[XB_XCNT(j)]); sum += c; cnt += (c > 0u) ? 1u : 0u; mine = (j == x) ? c : mine; }
        if (sum == G) break;
        __builtin_amdgcn_s_sleep(1);
        if ((++sp & 255u) == 0u) { if (xb_ld(&bar[XB_TMO])) break; if (sp > XB_SPIN_CAP) { atomicAdd(&bar[XB_TMO], 1u); break; } }
    }
    nloc = mine > 0u ? mine : 1u; nx = cnt > 0u ? cnt : 1u;
}

__device__ __forceinline__ void xcd_barrier(const XcdBarrier& b) {
    asm volatile("s_waitcnt vmcnt(0)" ::: "memory");
    __syncthreads();
    if (threadIdx.x == 0) {
        unsigned* bar = b.bar;
        __builtin_amdgcn_s_waitcnt(0);
        unsigned nloc = b.st[0], nx = b.st[1];
        if (nloc == 0u) { xcd_barrier_complete(bar, b.x, nloc, nx); b.st[0] = nloc; b.st[1] = nx; }
        const unsigned old = xb_add(&bar[XB_XSUB(b.x)], 1u);
        const unsigned gen = old / nloc;
        if (old + 1u == (gen + 1u) * nloc) {
            __builtin_amdgcn_fence(__ATOMIC_RELEASE, "agent");
            asm volatile("s_waitcnt vmcnt(0)" ::: "memory");
            const unsigned og = xb_add(&bar[XB_TOP], 1u);
            const unsigned tg = og / nx;
            if (og + 1u == (tg + 1u) * nx) xb_add(&bar[XB_TOPGEN], 1u);
            else XB_SPIN(xb_ld(&bar[XB_TOPGEN]) == tg, bar);
            __builtin_amdgcn_fence(__ATOMIC_ACQUIRE, "agent");
            xb_add(&bar[XB_XGEN(b.x)], 1u);
            asm volatile("s_waitcnt vmcnt(0)" ::: "memory");
        } else {
            XB_SPIN(xb_ld(&bar[XB_XGEN(b.x)]) == gen, bar);
            __builtin_amdgcn_fence(__ATOMIC_ACQUIRE, "agent");
            asm volatile("s_waitcnt vmcnt(0)" ::: "memory");
        }
    }
    __syncthreads();
}


constexpr int PPL = PEER_PART ? 10 : 8;
constexpr int NPHASE = 1 + 2 * PPL;
__device__ __forceinline__ void run_phase(const Params& p, int ph, int xcc, u16* sm) {
  if (ph == 0) { phase0(p, (float*)sm); return; }
  int l = (ph - 1) / PPL, s = (ph - 1) % PPL;
  switch (s) {
    case 0: phase_norm(p, l, 0); break;
    case 1: gemm_phase<0, 2048, 1024, 2048>(p, l, (const u16*)(p.ws + OFF_HBUF), (const u16*)(p.ws + OFF_WTIN) + (size_t)l * 2048 * 1024,
                          (u16*)(p.ws + OFF_PROJ), sm); break;
    case 2: phase_prep(p, l, sm); break;
    case 3: phase_mix(p, l, sm); break;
    case 4: gemm_phase<1, 1024, 1024, 1024>(p, l, (const u16*)(p.ws + OFF_MIX), (const u16*)(p.ws + OFF_WTOUT) + (size_t)l * 1024 * 1024,
                          nullptr, sm); break;
    case 5: phase_norm(p, l, 1); break;
    case 6: gemm_phase<0, 1024, 1024, 1024>(p, l, (const u16*)(p.ws + OFF_HBUF), (const u16*)(p.ws + OFF_WTQ) + (size_t)l * 1024 * 1024,
                          (u16*)(p.ws + OFF_QP), sm); break;
    case 7: phase_peer(p, l, sm); break;
#if PEER_PART
    case 8: phase_peer_u(p, l, xcc, sm); break;
    case 9: phase_peer_v(p, l); break;
#endif
  }
}

__global__ void __launch_bounds__(256, 2) mega(Params p, int ph_lo, int ph_hi) {
  __shared__ __attribute__((aligned(16))) u16 sm[32768];
  cg::grid_group grid = cg::this_grid();
  uint4* xbw = (uint4*)(sm + 32760);
  if (threadIdx.x == 0) *xbw = make_uint4(0u, 0u, 0u, 0u);
  __syncthreads();
  XcdBarrier xb = xcd_barrier_post((unsigned*)(p.ws + OFF_BAR), (volatile LAS unsigned*)xbw);
  if (ph_hi == 0x7fffffff) grid.sync();
  for (int ph = ph_lo; ph <= ph_hi; ++ph) {
    if (ph == 1 + PPL) continue;
    run_phase(p, ph, (int)(xb.x & 7u), sm);
#ifdef REP_PHASE
    if (ph == REP_PHASE) { xcd_barrier(xb); run_phase(p, ph, (int)(xb.x & 7u), sm); }
#endif
    if (ph < ph_hi) xcd_barrier(xb);
  }
}

extern "C" void kernel_launch(void* const* d_in, const int* in_sizes, int n_in, void* d_out, int out_size, void* d_ws, size_t ws_size,
                              hipStream_t stream) {
  static int grid_blocks = 0;
  if (!grid_blocks) {
    int dev = 0, cus = 0, per_cu = 0;
    hipGetDevice(&dev);
    hipDeviceGetAttribute(&cus, hipDeviceAttributeMultiprocessorCount, dev);
    hipOccupancyMaxActiveBlocksPerMultiprocessor(&per_cu, mega, 256, 0);
    if (per_cu > 2) per_cu = 2;
    if (per_cu < 1) per_cu = 1;
    grid_blocks = cus * per_cu;
  }
  if (ws_size < WS_NEED) { fprintf(stderr, "workspace too small: %zu < %zu\n", ws_size, (size_t)WS_NEED); return; }
  Params p{};
  const float** pf = (const float**)&p;
  for (int i = 0; i < 32; ++i) pf[i] = (const float*)d_in[i];
  p.out = (float*)d_out;
  p.ws = (char*)d_ws;
  hipMemsetAsync((char*)d_ws + OFF_BAR, 0, 16384, stream);
#if ONE_LAUNCH
  int lo = 0, hi = NPHASE - 1;
  void* args[] = {&p, &lo, &hi};
  hipError_t e = hipLaunchCooperativeKernel((void*)mega, dim3(grid_blocks), dim3(256), args, 0, stream);
  if (e != hipSuccess) fprintf(stderr, "cooperative launch failed: %s (grid %d)\n", hipGetErrorString(e), grid_blocks);
#else
  for (int ph = 0; ph < NPHASE; ++ph) {
    int lo = ph, hi = ph;
    void* args[] = {&p, &lo, &hi};
    hipError_t e = hipLaunchCooperativeKernel((void*)mega, dim3(grid_blocks), dim3(256), args, 0, stream);
    if (e != hipSuccess) fprintf(stderr, "cooperative launch failed: %s (grid %d)\n", hipGetErrorString(e), grid_blocks);
  }
#endif
}
```
